# Optimizing an MI355X kernel written in HIP

```python
import jax, jax.numpy as jnp
from jax import lax
import numpy as np

D_MODEL = 2048
BATCH = 2
SEQ = 16384
DEPTH = 2

N_MIXERS = 2
N_LAYERS_A = (DEPTH + 1) // 2
N_LAYERS_B = DEPTH // 2
D_FF = 4 * D_MODEL
PLE_DIM = 256
ROPE_THETA = 500000.0
EPS = 1e-6

GM_WIDTH = D_MODEL
GM_CHUNK = 128
GM_GROUPS = 16
GM_GROUP_DIM = GM_WIDTH // GM_GROUPS

NSA_HEADS = 16
NSA_KV_GROUPS = 4
NSA_HPG = NSA_HEADS // NSA_KV_GROUPS
HEAD_DIM = 128
ROT_DIM = HEAD_DIM // 4
CMP_LEN = 32
CMP_STRIDE = 16
CMP_HIDDEN = 4 * HEAD_DIM
SEL_BLOCK = 64
SEL_TOPK = 16
WINDOW = 512
Q_BLOCK = 128
NSA_IN_DIM = NSA_HEADS * HEAD_DIM + 6 * NSA_KV_GROUPS * HEAD_DIM + 3 * NSA_HEADS
NEG_INF = -1e30
FORCE_SCORE = 1e9

kernel_name = "hybrid_gmlp_nsa_trunk"


def rmsnorm(x, g):
    xf = x.astype(jnp.float32)
    y = xf * lax.rsqrt(jnp.mean(xf * xf, axis=-1, keepdims=True) + EPS)
    return (y * g.astype(jnp.float32)).astype(x.dtype)


def layernorm(x, g, b):
    xf = x.astype(jnp.float32)
    mu = jnp.mean(xf, axis=-1, keepdims=True)
    var = jnp.mean(jnp.square(xf - mu), axis=-1, keepdims=True)
    y = (xf - mu) * lax.rsqrt(var + EPS)
    return (y * g.astype(jnp.float32) + b.astype(jnp.float32)).astype(x.dtype)


def rope(x, pos):
    half = ROT_DIM // 2
    inv = jnp.power(jnp.float32(ROPE_THETA), -jnp.arange(half, dtype=jnp.float32) * 2.0 / ROT_DIM)
    ang = pos.astype(jnp.float32)[:, None] * inv[None, :]
    cos = jnp.cos(ang)[:, None, :]
    sin = jnp.sin(ang)[:, None, :]
    xr = x[..., :ROT_DIM].astype(jnp.float32)
    x1, x2 = xr[..., :half], xr[..., half:]
    rot = jnp.concatenate([x1 * cos - x2 * sin, x2 * cos + x1 * sin], axis=-1).astype(x.dtype)
    return jnp.concatenate([rot, x[..., ROT_DIM:]], axis=-1)


def masked_softmax(s, mask):
    s = jnp.where(mask, s, NEG_INF)
    p = jax.nn.softmax(s, axis=-1)
    return jnp.where(mask, p, 0.0)


def chunked_gmlp(h, w_in, ln_g, ln_b, w_s, b_s, w_out):
    B, T, _ = h.shape
    z = jax.nn.gelu(h @ w_in)
    u, v = jnp.split(z, 2, axis=-1)
    v = layernorm(v, ln_g, ln_b)
    v = v.reshape(B, T // GM_CHUNK, GM_CHUNK, GM_GROUPS, GM_GROUP_DIM)
    causal = jnp.tril(jnp.ones((GM_CHUNK, GM_CHUNK), dtype=bool))
    ws = jnp.where(causal[None], w_s, jnp.zeros((), w_s.dtype))
    sv = jnp.einsum('gts,bcsgd->bctgd', ws, v) + b_s.T[None, None, :, :, None]
    return (u * sv.reshape(B, T, GM_WIDTH)) @ w_out


def compress(k, pe, w1, w2):
    B, T, G, dk = k.shape
    nc = (T - CMP_LEN) // CMP_STRIDE + 1
    idx = np.arange(nc)[:, None] * CMP_STRIDE + np.arange(CMP_LEN)[None, :]
    blk = k[:, idx] + pe[None, None, :, None, :]
    blk = blk.transpose(0, 1, 3, 2, 4).reshape(B, nc, G, CMP_LEN * dk)
    return jax.nn.gelu(blk @ w1) @ w2


def native_sparse_attention(h, w_in, kc_pe, kc_w1, kc_w2, vc_pe, vc_w1, vc_w2, w_out):
    B, T, _ = h.shape
    G, N, Dh, H = NSA_KV_GROUPS, NSA_HPG, HEAD_DIM, NSA_HEADS
    sizes = [H * Dh] + [G * Dh] * 6 + [3 * H]
    splits = [int(s) for s in np.cumsum(sizes)[:-1]]
    q, kc, vc, ks, vs, kw, vw, gl = jnp.split(h @ w_in, splits, axis=-1)
    pos = jnp.arange(T)
    q = (rope(q.reshape(B, T, H, Dh), pos) * (HEAD_DIM ** -0.5)).reshape(B, T, G, N, Dh)
    nc = (T - CMP_LEN) // CMP_STRIDE + 1
    cmp_end_np = np.arange(nc) * CMP_STRIDE + CMP_LEN - 1
    cmp_end = jnp.asarray(cmp_end_np, dtype=jnp.int32)
    kc = rope(compress(kc.reshape(B, T, G, Dh), kc_pe, kc_w1, kc_w2), cmp_end)
    vc = compress(vc.reshape(B, T, G, Dh), vc_pe, vc_w1, vc_w2)
    ks = rope(ks.reshape(B, T, G, Dh), pos)
    kw = rope(kw.reshape(B, T, G, Dh), pos)
    ns = T // SEL_BLOCK
    sel_k = min(SEL_TOPK, ns)
    ks_b = ks.reshape(B, ns, SEL_BLOCK, G, Dh).transpose(0, 3, 1, 2, 4)
    vs_b = vs.reshape(B, ns, SEL_BLOCK, G, Dh).transpose(0, 3, 1, 2, 4)
    pad = ((0, 0), (WINDOW, 0), (0, 0), (0, 0))
    kw_pad = jnp.pad(kw, pad)
    vw_pad = jnp.pad(vw.reshape(B, T, G, Dh), pad)
    gates = jax.nn.sigmoid(gl).reshape(B, T, 3, G, N, 1)
    cs = np.arange(nc)[:, None] * CMP_STRIDE
    ss = np.arange(ns)[None, :] * SEL_BLOCK
    ov = np.clip(np.minimum(cs + CMP_LEN, ss + SEL_BLOCK) - np.maximum(cs, ss), 0, None) / CMP_STRIDE
    cmp_to_sel = jnp.asarray(ov, dtype=jnp.float32)
    bi = jnp.arange(B)[:, None, None, None]
    gi = jnp.arange(G)[None, :, None, None]
    blk_id = jnp.arange(ns)

    def query_block(qb):
        t0 = qb * Q_BLOCK
        tpos = t0 + jnp.arange(Q_BLOCK)
        qblk = lax.dynamic_slice_in_dim(q, t0, Q_BLOCK, axis=1)
        s_c = jnp.einsum('bqgnd,bcgd->bgnqc', qblk, kc, preferred_element_type=jnp.float32)
        p_c = masked_softmax(s_c, cmp_end[None, :] <= tpos[:, None])
        o_c = jnp.einsum('bgnqc,bcgd->bqgnd', p_c.astype(vc.dtype), vc)
        imp = jnp.einsum('bgnqc,cs->bgqs', p_c, cmp_to_sel)
        cur = tpos // SEL_BLOCK
        valid = blk_id[None, :] <= cur[:, None]
        forced = (blk_id[None, :] == 0) | (blk_id[None, :] == cur[:, None]) | (blk_id[None, :] == cur[:, None] - 1)
        score = jnp.where(valid, jnp.where(forced, FORCE_SCORE, imp), NEG_INF)
        top_s, top_i = lax.top_k(score, sel_k)
        kg = ks_b[bi, gi, top_i]
        vg = vs_b[bi, gi, top_i]
        s_s = jnp.einsum('bqgnd,bgqkjd->bgnqkj', qblk, kg, preferred_element_type=jnp.float32)
        kpos = top_i[..., None] * SEL_BLOCK + jnp.arange(SEL_BLOCK)
        m_s = (kpos <= tpos[None, None, :, None, None]) & (top_s > NEG_INF * 0.5)[..., None]
        p_s = masked_softmax(s_s.reshape(B, G, N, Q_BLOCK, -1),
                             m_s.reshape(B, G, 1, Q_BLOCK, -1)).reshape(s_s.shape)
        o_s = jnp.einsum('bgnqkj,bgqkjd->bqgnd', p_s.astype(vg.dtype), vg)
        kwin = lax.dynamic_slice_in_dim(kw_pad, t0, WINDOW + Q_BLOCK, axis=1)
        vwin = lax.dynamic_slice_in_dim(vw_pad, t0, WINDOW + Q_BLOCK, axis=1)
        kp = t0 - WINDOW + jnp.arange(WINDOW + Q_BLOCK)
        m_w = (kp[None, :] <= tpos[:, None]) & (kp[None, :] > tpos[:, None] - WINDOW) & (kp[None, :] >= 0)
        s_w = jnp.einsum('bqgnd,bkgd->bgnqk', qblk, kwin, preferred_element_type=jnp.float32)
        p_w = masked_softmax(s_w, m_w)
        o_w = jnp.einsum('bgnqk,bkgd->bqgnd', p_w.astype(vwin.dtype), vwin)
        g = lax.dynamic_slice_in_dim(gates, t0, Q_BLOCK, axis=1)
        o = g[:, :, 0] * o_c + g[:, :, 1] * o_s + g[:, :, 2] * o_w
        return o.reshape(B, Q_BLOCK, H * Dh)

    out = lax.map(query_block, jnp.arange(T // Q_BLOCK))
    out = out.transpose(1, 0, 2, 3).reshape(B, T, H * Dh)
    return out @ w_out


def sqrelu_mlp(h, w_up, w_down):
    return jnp.square(jax.nn.relu(h @ w_up)) @ w_down


def setup_inputs(seed: int = 0) -> dict:
    key = jax.random.key(seed)
    ks = jax.random.split(key, 32)
    f32 = jnp.float32

    def nrm(k, shape, scale):
        return jax.random.normal(k, shape, f32) * scale

    def gain(k, shape):
        return 1.0 + 0.05 * jax.random.normal(k, shape, f32)

    return {
        "x": nrm(ks[0], (BATCH, SEQ, D_MODEL), 1.0),
        "p": nrm(ks[1], (DEPTH, BATCH, SEQ, PLE_DIM), 1.0),
        "norm_mix": gain(ks[2], (DEPTH, D_MODEL)),
        "norm_ffn": gain(ks[3], (DEPTH, D_MODEL)),
        "norm_ple": gain(ks[4], (DEPTH, D_MODEL)),
        "ffn_up": nrm(ks[5], (DEPTH, D_MODEL, D_FF), D_MODEL ** -0.5),
        "ffn_down": nrm(ks[6], (DEPTH, D_FF, D_MODEL), D_FF ** -0.5),
        "ple_proj": nrm(ks[7], (DEPTH, PLE_DIM, D_MODEL), PLE_DIM ** -0.5),
        "ple_gate": nrm(ks[8], (DEPTH, D_MODEL, D_MODEL), D_MODEL ** -0.5),
        "gm_in": nrm(ks[9], (N_LAYERS_A, D_MODEL, 2 * GM_WIDTH), D_MODEL ** -0.5),
        "gm_ln_g": gain(ks[10], (N_LAYERS_A, GM_WIDTH)),
        "gm_ln_b": nrm(ks[11], (N_LAYERS_A, GM_WIDTH), 0.02),
        "gm_ws": nrm(ks[12], (N_LAYERS_A, GM_GROUPS, GM_CHUNK, GM_CHUNK), GM_CHUNK ** -0.5),
        "gm_bs": 1.0 + nrm(ks[13], (N_LAYERS_A, GM_GROUPS, GM_CHUNK), 0.1),
        "gm_out": nrm(ks[14], (N_LAYERS_A, GM_WIDTH, D_MODEL), GM_WIDTH ** -0.5),
        "nsa_in": nrm(ks[15], (N_LAYERS_B, D_MODEL, NSA_IN_DIM), D_MODEL ** -0.5),
        "nsa_kc_pe": nrm(ks[16], (N_LAYERS_B, CMP_LEN, HEAD_DIM), 0.1),
        "nsa_kc_w1": nrm(ks[17], (N_LAYERS_B, CMP_LEN * HEAD_DIM, CMP_HIDDEN), (CMP_LEN * HEAD_DIM) ** -0.5),
        "nsa_kc_w2": nrm(ks[18], (N_LAYERS_B, CMP_HIDDEN, HEAD_DIM), CMP_HIDDEN ** -0.5),
        "nsa_vc_pe": nrm(ks[19], (N_LAYERS_B, CMP_LEN, HEAD_DIM), 0.1),
        "nsa_vc_w1": nrm(ks[20], (N_LAYERS_B, CMP_LEN * HEAD_DIM, CMP_HIDDEN), (CMP_LEN * HEAD_DIM) ** -0.5),
        "nsa_vc_w2": nrm(ks[21], (N_LAYERS_B, CMP_HIDDEN, HEAD_DIM), CMP_HIDDEN ** -0.5),
        "nsa_out": nrm(ks[22], (N_LAYERS_B, NSA_HEADS * HEAD_DIM, D_MODEL), (NSA_HEADS * HEAD_DIM) ** -0.5),
        "final_norm": gain(ks[23], (D_MODEL,)),
    }


def reference(x, p, norm_mix, norm_ffn, norm_ple, ffn_up, ffn_down, ple_proj, ple_gate,
              gm_in, gm_ln_g, gm_ln_b, gm_ws, gm_bs, gm_out,
              nsa_in, nsa_kc_pe, nsa_kc_w1, nsa_kc_w2, nsa_vc_pe, nsa_vc_w1, nsa_vc_w2, nsa_out,
              final_norm):
    for i in range(DEPTH):
        h = rmsnorm(x, norm_mix[i])
        j = i // N_MIXERS
        if i % N_MIXERS == 0:
            mix = chunked_gmlp(h, gm_in[j], gm_ln_g[j], gm_ln_b[j], gm_ws[j], gm_bs[j], gm_out[j])
        else:
            mix = native_sparse_attention(h, nsa_in[j], nsa_kc_pe[j], nsa_kc_w1[j], nsa_kc_w2[j],
                                          nsa_vc_pe[j], nsa_vc_w1[j], nsa_vc_w2[j], nsa_out[j])
        x = x + mix
        x = x + sqrelu_mlp(rmsnorm(x, norm_ffn[i]), ffn_up[i], ffn_down[i])
        gate = jax.nn.sigmoid(rmsnorm(x, norm_ple[i]) @ ple_gate[i])
        x = x + gate * (p[i] @ ple_proj[i])
    return rmsnorm(x, final_norm)
```

```cpp
#include <hip/hip_runtime.h>
#include <hip/hip_cooperative_groups.h>
#include <cstdio>
#include <cstdint>
namespace cg = cooperative_groups;

#define LAS __attribute__((address_space(3)))
#define DI __device__ __forceinline__
typedef unsigned short bf16_t;
typedef short bf16x8 __attribute__((ext_vector_type(8)));
typedef short s16x4 __attribute__((ext_vector_type(4)));
typedef float f32x4 __attribute__((ext_vector_type(4)));
typedef float f32x2 __attribute__((ext_vector_type(2)));
typedef unsigned u32x4 __attribute__((ext_vector_type(4)));
typedef unsigned u32x2 __attribute__((ext_vector_type(2)));

constexpr int MT = 32768, TT = 16384, DM = 2048, DFF = 8192, PLE = 256;
constexpr int NQKV = 5376, NQKV_REAL = 5168;
constexpr int C_Q = 0, C_KC = 2048, C_VC = 2560, C_KS = 3072, C_VS = 3584, C_KW = 4096, C_VW = 4608, C_GL = 5120;
constexpr int NTHREADS = 512;
constexpr int LDS_BYTES = 133136;
constexpr int BARST_OFF = 133120;

DI int TID() { int t = threadIdx.x; asm volatile("" : "+v"(t)); return t; }
DI int BID() { int b = blockIdx.x; asm volatile("" : "+s"(b)); return b; }
DI unsigned cvt_pk_bf16(float lo, float hi) { unsigned r; asm volatile("v_cvt_pk_bf16_f32 %0, %1, %2" : "=v"(r) : "v"(lo), "v"(hi)); return r; }
DI float bf2f(bf16_t b) { return __uint_as_float(((unsigned)b) << 16); }
DI float bflo(unsigned w) { return __uint_as_float(w << 16); }
DI float bfhi(unsigned w) { return __uint_as_float(w & 0xffff0000u); }
DI bf16_t f2bf(float f) { return (bf16_t)(cvt_pk_bf16(f, 0.f) & 0xffffu); }
DI float gelu_tanh(float x) { const float u = 0.7978845608028654f * (x + 0.044715f * x * x * x); return x / (1.f + __expf(-2.f * u)); }
DI float sigmoidf_(float x) { return 1.f / (1.f + __expf(-x)); }
DI float xsum_fq(float x) {
    auto a = __builtin_amdgcn_permlane16_swap(__float_as_uint(x), __float_as_uint(x), false, false); x = __uint_as_float(a[0]) + __uint_as_float(a[1]);
    auto b = __builtin_amdgcn_permlane32_swap(__float_as_uint(x), __float_as_uint(x), false, false); return __uint_as_float(b[0]) + __uint_as_float(b[1]);
}
DI float row_rstd(const float* __restrict__ part, int row, int fq) {
    const f32x4 a = *(const f32x4*)(part + (size_t)row * 32 + fq * 8), b = *(const f32x4*)(part + (size_t)row * 32 + fq * 8 + 4);
    const float s = xsum_fq((a[0] + a[1]) + (a[2] + a[3]) + (b[0] + b[1]) + (b[2] + b[3]));
    return rsqrtf(s * (1.f / DM) + 1e-6f);
}

namespace pg8 {
constexpr int BM = 256, BK = 64, HALF = 128, HTB = HALF * BK * 2, STAGE_BYTES = 8 * HTB, NXCD = 8, WGM = 8;
DI int lds_byte(int r, int c) { const int st = (r >> 4) * 2 + (c >> 5), rr = r & 15, cc = c & 31, ob = rr * 64 + cc * 2; return st * 1024 + (ob ^ (((ob >> 9) & 1) << 5)); }
DI void stage_rc(int b, int& R, int& C) { const int st = b / 1024, sb = b % 1024, swz = sb ^ (((sb >> 9) & 1) << 5); R = (st >> 1) * 16 + swz / 64; C = (st & 1) * 32 + (swz % 64) / 2; }
DI int perm32(int rho) { const int n = rho >> 4, i = rho & 15; return 8 * (i >> 2) + 4 * n + (i & 3); }
struct Unit { int pm, pn; };
struct StaticOrder {
    int nM, nN, nwg, G, c;
    DI void init(int M, int N, int G_, int c_) { nM = M / BM; nN = N / BM; nwg = nM * nN; G = G_; c = c_; }
    DI bool next(int i, Unit& u) const {
        const long L = (long)i * G + c; if (L >= nwg) return false;
        int wgid = (int)L; { const int q = nwg / NXCD, r = nwg % NXCD, xcd = wgid % NXCD, off = wgid / NXCD; wgid = (xcd < r ? xcd * (q + 1) : r * (q + 1) + (xcd - r) * q) + off; }
        const int nig = WGM * nN, gid = wgid / nig, fm = gid * WGM, gsz = (nM - fm) < WGM ? (nM - fm) : WGM;
        u.pm = fm + ((wgid % nig) % gsz); u.pn = (wgid % nig) / gsz; return true;
    }
};
template <int MODE> struct Gemm {
    const char* A; const char* Bt; int M, N, nt; unsigned lda, ldb, kstep2;
    DI const char* aptr(int pm) const {
        if (MODE == 0) return A + (size_t)pm * 256 * lda;
        const int kv = pm >> 5, bg = (pm >> 2) & 7, panel = pm & 3, b = bg >> 2, g = bg & 3;
        return A + ((size_t)(b * TT + panel * 4096) * NQKV + C_KC + kv * 512 + g * 128) * 2;
    }
    DI const char* bptr(int pm, int pn) const {
        if (MODE == 0) return Bt + (size_t)pn * 256 * ldb;
        return Bt + (size_t)(pm >> 5) * (512 * 4096 * 2) + (size_t)pn * 256 * ldb;
    }
};

template <class Epi, int MODE>
DI void gemm_phase(LAS unsigned char* lds, const Gemm<MODE> g, const StaticOrder& S, const Epi& E) {
    const int tid = TID(), wid = __builtin_amdgcn_readfirstlane(tid >> 6), lane = tid & 63, wr = wid >> 2, wc = wid & 3, fr = lane & 15, fq = lane >> 4;
    const int nt = g.nt;
    unsigned voffA[2], voffB[2];
#pragma unroll
    for (int i = 0; i < 2; ++i) { int R, C; stage_rc(tid * 16 + i * 8192, R, C); const int Rb = Epi::PERM ? ((R & ~31) + perm32(R & 31)) : R;
        voffA[i] = (unsigned)R * g.lda + (unsigned)C * 2u; voffB[i] = (unsigned)Rb * g.ldb + (unsigned)C * 2u; }
    const size_t kstep = 128;
    const size_t hstepA = (size_t)HALF * g.lda, hstepB = (size_t)HALF * g.ldb;
    const size_t kstep2 = g.kstep2;
    const unsigned ldsw = (unsigned)wid * 1024u;
    const int aoff = lds_byte(wr * 64 + fr, fq * 8), boff = lds_byte(wc * 32 + fr, fq * 8);
#define PG8_SA(b, h) (((b) * 2 + (h)) * HTB)
#define PG8_SB(b, h) ((4 + (b) * 2 + (h)) * HTB)
#define PG8_STAGE(bufoff, gbase, voff) do { _Pragma("unroll") for (int _i = 0; _i < 2; ++_i) \
        __builtin_amdgcn_global_load_lds((const unsigned*)((const char*)(gbase) + (voff)[_i]), (LAS unsigned*)(lds + (bufoff) + ldsw + _i * 8192), 16, 0, 0); } while (0)
#define PG8_LDA(dst, b, h) do { _Pragma("unroll") for (int m = 0; m < 4; ++m) _Pragma("unroll") for (int k = 0; k < 2; ++k) dst[m][k] = *(const LAS bf16x8*)(lds + PG8_SA(b, h) + aoff + m * 2048 + k * 1024); } while (0)
#define PG8_LDB(dst, b, h) do { _Pragma("unroll") for (int n = 0; n < 2; ++n) _Pragma("unroll") for (int k = 0; k < 2; ++k) dst[n][k] = *(const LAS bf16x8*)(lds + PG8_SB(b, h) + boff + n * 2048 + k * 1024); } while (0)
#define PG8_MMA(ai, bj, At, Bt) do { __builtin_amdgcn_s_setprio(1); _Pragma("unroll") for (int m = 0; m < 4; ++m) _Pragma("unroll") for (int n = 0; n < 2; ++n) _Pragma("unroll") for (int k = 0; k < 2; ++k) \
        acc[ai][bj][m][n] = __builtin_amdgcn_mfma_f32_16x16x32_bf16(Bt[n][k], At[m][k], acc[ai][bj][m][n], 0, 0, 0); __builtin_amdgcn_s_setprio(0); } while (0)
#define PG8_WAIT_V(n) asm volatile("s_waitcnt vmcnt(" #n ")" ::: "memory")
#define PG8_WAIT_L(n) asm volatile("s_waitcnt lgkmcnt(" #n ")" ::: "memory")
#define PG8_BAR __builtin_amdgcn_s_barrier()
#define PG8_SCHED __builtin_amdgcn_sched_barrier(0)
    Unit cur, nxt; int ui = 0;
    if (!S.next(0, cur)) return;
    f32x4 acc[2][2][4][2];
#pragma unroll
    for (int a = 0; a < 2; ++a)
#pragma unroll
        for (int b = 0; b < 2; ++b)
#pragma unroll
            for (int m = 0; m < 4; ++m)
#pragma unroll
                for (int n = 0; n < 2; ++n) acc[a][b][m][n] = (f32x4){0.f, 0.f, 0.f, 0.f};
    bf16x8 At[4][2], B0[2][2], B1[2][2];
    const char* cA = g.aptr(cur.pm); const char* cB = g.bptr(cur.pm, cur.pn);
    PG8_STAGE(PG8_SB(0, 0), cB, voffB); PG8_STAGE(PG8_SA(0, 0), cA, voffA); PG8_STAGE(PG8_SB(0, 1), cB + hstepB, voffB); PG8_STAGE(PG8_SA(0, 1), cA + hstepA, voffA);
    if (wr == 1) PG8_BAR;
    PG8_WAIT_V(4); PG8_BAR;
    PG8_STAGE(PG8_SB(1, 0), cB + kstep, voffB); PG8_STAGE(PG8_SA(1, 0), cA + kstep, voffA); PG8_STAGE(PG8_SB(1, 1), cB + hstepB + kstep, voffB);
    PG8_WAIT_V(6); PG8_BAR;
    for (;;) {
        const bool has_next = S.next(ui + 1, nxt);
        const char* nA = has_next ? g.aptr(nxt.pm) : cA; const char* nB = has_next ? g.bptr(nxt.pm, nxt.pn) : cB;
        for (int t = 0; t < nt; t += 2) {
            const bool last = (t == nt - 2);
            const char* a1 = cA + (size_t)(t >> 1) * kstep2 + kstep;
            const char* a2 = last ? nA : cA + (size_t)((t + 2) >> 1) * kstep2; const char* b2 = last ? nB : cB + (size_t)(t + 2) * kstep;
            const char* a3 = a2 + kstep; const char* b3 = b2 + kstep;
            PG8_LDB(B0, 0, 0); PG8_SCHED; PG8_LDA(At, 0, 0); PG8_STAGE(PG8_SA(1, 1), a1 + hstepA, voffA);
            PG8_WAIT_L(8); PG8_BAR; PG8_WAIT_L(0); PG8_MMA(0, 0, At, B0); PG8_BAR; PG8_SCHED;
            PG8_LDB(B1, 0, 1); PG8_STAGE(PG8_SB(0, 0), b2, voffB);
            PG8_BAR; PG8_WAIT_L(0); PG8_MMA(0, 1, At, B1); PG8_BAR;
            PG8_LDA(At, 0, 1); PG8_STAGE(PG8_SA(0, 0), a2, voffA);
            PG8_BAR; PG8_WAIT_L(0); PG8_MMA(1, 0, At, B0); PG8_BAR; PG8_SCHED;
            PG8_STAGE(PG8_SB(0, 1), b2 + hstepB, voffB);
            PG8_WAIT_V(6); PG8_BAR; PG8_MMA(1, 1, At, B1); PG8_BAR;
            PG8_LDB(B0, 1, 0); PG8_SCHED; PG8_LDA(At, 1, 0); PG8_STAGE(PG8_SA(0, 1), a2 + hstepA, voffA);
            PG8_WAIT_L(8); PG8_BAR; PG8_WAIT_L(0); PG8_MMA(0, 0, At, B0); PG8_BAR; PG8_SCHED;
            PG8_LDB(B1, 1, 1); PG8_STAGE(PG8_SB(1, 0), b3, voffB);
            PG8_BAR; PG8_WAIT_L(0); PG8_MMA(0, 1, At, B1); PG8_BAR;
            PG8_LDA(At, 1, 1); PG8_STAGE(PG8_SA(1, 0), a3, voffA);
            PG8_BAR; PG8_WAIT_L(0); PG8_MMA(1, 0, At, B0); PG8_BAR; PG8_SCHED;
            PG8_STAGE(PG8_SB(1, 1), b3 + hstepB, voffB);
            PG8_WAIT_V(6); PG8_BAR; PG8_MMA(1, 1, At, B1); PG8_BAR;
        }
        E(acc, cur, wr, wc, fr, fq);
        if (!has_next) break;
#pragma unroll
        for (int a = 0; a < 2; ++a)
#pragma unroll
            for (int b = 0; b < 2; ++b)
#pragma unroll
                for (int m = 0; m < 4; ++m)
#pragma unroll
                    for (int n = 0; n < 2; ++n) acc[a][b][m][n] = (f32x4){0.f, 0.f, 0.f, 0.f};
        cur = nxt; cA = nA; cB = nB; ++ui;
    }
    PG8_WAIT_V(0);
    if (wr == 0) PG8_BAR;
    PG8_BAR;
#undef PG8_SA
#undef PG8_SB
#undef PG8_STAGE
#undef PG8_LDA
#undef PG8_LDB
#undef PG8_MMA
#undef PG8_WAIT_V
#undef PG8_WAIT_L
#undef PG8_BAR
#undef PG8_SCHED
}

template <int ACT, bool BIASPM> struct EpiAct {
    static constexpr bool PERM = true;
    bf16_t* O; int ldc; const float* bias; const float* part;
    DI void operator()(const f32x4 (&acc)[2][2][4][2], const Unit& u, int wr, int wc, int fr, int fq) const {
        const int row0 = u.pm * BM + wr * 64 + fr; const int col0 = u.pn * BM + wc * 32 + 8 * fq;
        f32x4 bv[2][2];
#pragma unroll
        for (int bj = 0; bj < 2; ++bj)
#pragma unroll
            for (int n = 0; n < 2; ++n) bv[bj][n] = BIASPM ? *(const f32x4*)(bias + (u.pm >> 5) * 512 + col0 + bj * HALF + 4 * n) : (f32x4){0.f, 0.f, 0.f, 0.f};
#pragma unroll
        for (int ai = 0; ai < 2; ++ai)
#pragma unroll
            for (int m = 0; m < 4; ++m) { const int row = row0 + ai * HALF + m * 16; bf16_t* rowp = O + (size_t)row * ldc + col0;
                const float rs = part ? row_rstd(part, row, fq) : 1.f;
#pragma unroll
                for (int bj = 0; bj < 2; ++bj) { f32x4 v0 = acc[ai][bj][m][0] * rs + bv[bj][0], v1 = acc[ai][bj][m][1] * rs + bv[bj][1];
                    if (ACT == 1) {
#pragma unroll
                        for (int j = 0; j < 4; ++j) { v0[j] = gelu_tanh(v0[j]); v1[j] = gelu_tanh(v1[j]); } }
                    if (ACT == 2) {
#pragma unroll
                        for (int j = 0; j < 4; ++j) { const float a = fmaxf(v0[j], 0.f), b = fmaxf(v1[j], 0.f); v0[j] = a * a; v1[j] = b * b; } }
                    u32x4 w; w.x = cvt_pk_bf16(v0[0], v0[1]); w.y = cvt_pk_bf16(v0[2], v0[3]); w.z = cvt_pk_bf16(v1[0], v1[1]); w.w = cvt_pk_bf16(v1[2], v1[3]);
                    *(u32x4*)(rowp + bj * HALF) = w; } }
    }
};
template <bool GATE> struct EpiResN {
    static constexpr bool PERM = false;
    const float* base; float* out; const bf16_t* pp; const float* part_in; const float* gnext; bf16_t* Hn; float* part_out;
    DI void operator()(const f32x4 (&acc)[2][2][4][2], const Unit& u, int wr, int wc, int fr, int fq) const {
        const int row0 = u.pm * BM + wr * 64 + fr, col0 = u.pn * BM + wc * 32 + 4 * fq;
        f32x4 gv[2][2];
#pragma unroll
        for (int bj = 0; bj < 2; ++bj)
#pragma unroll
            for (int n = 0; n < 2; ++n) gv[bj][n] = Hn ? *(const f32x4*)(gnext + col0 + bj * HALF + n * 16) : (f32x4){0.f, 0.f, 0.f, 0.f};
        constexpr int MB = GATE ? 1 : 2;
#pragma unroll
        for (int ai = 0; ai < 2; ++ai)
#pragma unroll
            for (int m0 = 0; m0 < 4; m0 += MB) {
                f32x4 bs[MB][4]; u32x2 pw[MB][4]; float rs[MB];
#pragma unroll
                for (int mm = 0; mm < MB; ++mm) { const int row = row0 + ai * HALF + (m0 + mm) * 16; const size_t off = (size_t)row * DM + col0;
#pragma unroll
                    for (int q = 0; q < 4; ++q) { const size_t o = off + (q >> 1) * HALF + (q & 1) * 16; bs[mm][q] = *(const f32x4*)(base + o); if (GATE) pw[mm][q] = *(const u32x2*)(pp + o); }
                    rs[mm] = GATE ? row_rstd(part_in, row, fq) : 1.f; }
#pragma unroll
                for (int mm = 0; mm < MB; ++mm) { const int m = m0 + mm, row = row0 + ai * HALF + m * 16; const size_t off = (size_t)row * DM + col0; float ss = 0.f;
#pragma unroll
                    for (int q = 0; q < 4; ++q) { const int bj = q >> 1, n = q & 1; const size_t o = off + bj * HALF + n * 16; const f32x4 b = bs[mm][q]; const f32x4 a = acc[ai][bj][m][n]; f32x4 r;
                        if (GATE) { const u32x2 w2 = pw[mm][q]; const float s = rs[mm];
                            r[0] = b[0] + sigmoidf_(a[0] * s) * bflo(w2.x); r[1] = b[1] + sigmoidf_(a[1] * s) * bfhi(w2.x); r[2] = b[2] + sigmoidf_(a[2] * s) * bflo(w2.y); r[3] = b[3] + sigmoidf_(a[3] * s) * bfhi(w2.y); }
                        else r = b + a;
                        *(f32x4*)(out + o) = r;
                        if (Hn) { ss += (r[0] * r[0] + r[1] * r[1]) + (r[2] * r[2] + r[3] * r[3]); const f32x4 g = gv[bj][n];
                            u32x2 w; w.x = cvt_pk_bf16(r[0] * g[0], r[1] * g[1]); w.y = cvt_pk_bf16(r[2] * g[2], r[3] * g[3]); *(u32x2*)(Hn + o) = w; } }
                    if (Hn) { ss = xsum_fq(ss); if (fq == 0) part_out[(size_t)row * 32 + u.pn * 4 + wc] = ss; } }
            }
    }
};
}
#define XB_TMO      128
#define XB_XCNT(j)  (256  + 64 * (j))
#define XB_XSUB(j)  (1280 + 64 * (j))
#define XB_XGEN(j)  (2304 + 64 * (j))
#define XB_TOP      3328
#define XB_TOPGEN   3392
#define XCD_BAR_WORDS 3456
#define XB_SPIN_CAP (1u << 18)

__device__ __forceinline__ unsigned xb_ld(unsigned* p)              { return __hip_atomic_load(p, __ATOMIC_RELAXED, __HIP_MEMORY_SCOPE_AGENT); }
__device__ __forceinline__ unsigned xb_add(unsigned* p, unsigned v) { return __hip_atomic_fetch_add(p, v, __ATOMIC_RELAXED, __HIP_MEMORY_SCOPE_AGENT); }
__device__ __forceinline__ unsigned xb_xcc_id() { return (unsigned)__builtin_amdgcn_s_getreg((3 << 11) | 20) & 0xFu; }
#define XB_SPIN(cond, bar) do { unsigned _sp = 0; while (cond) { __builtin_amdgcn_s_sleep(1); \
    if ((++_sp & 255u) == 0u) { if (xb_ld(&(bar)[XB_TMO])) break; if (_sp > XB_SPIN_CAP) { atomicAdd(&(bar)[XB_TMO], 1u); break; } } } } while (0)

struct XcdBarrier {
    unsigned* bar; unsigned x;
    volatile LAS unsigned* st;
};

__device__ __forceinline__ XcdBarrier xcd_barrier_post(unsigned* bar, volatile LAS unsigned* st) {
    XcdBarrier b; b.bar = bar; b.x = xb_xcc_id(); b.st = st;
    if (threadIdx.x == 0) (void)xb_add(&bar[XB_XCNT(b.x)], 1u);
    return b;
}
__device__ __forceinline__ void xcd_barrier_complete(unsigned* bar, unsigned x, unsigned& nloc, unsigned& nx) {
    const unsigned G = gridDim.x * gridDim.y * gridDim.z;
    unsigned sum, cnt, mine, sp = 0u;
    for (;;) {
        sum = 0u; cnt = 0u; mine = 0u;
#pragma unroll
        for (unsigned j = 0; j < 16; ++j) { const unsigned c = xb_ld(&bar[XB_XCNT(j)]); sum += c; cnt += (c > 0u) ? 1u : 0u; mine = (j == x) ? c : mine; }
        if (sum == G) break;
        __builtin_amdgcn_s_sleep(1);
        if ((++sp & 255u) == 0u) { if (xb_ld(&bar[XB_TMO])) break; if (sp > XB_SPIN_CAP) { atomicAdd(&bar[XB_TMO], 1u); break; } }
    }
    nloc = mine > 0u ? mine : 1u; nx = cnt > 0u ? cnt : 1u;
}

__device__ __forceinline__ void xcd_barrier(const XcdBarrier& b) {
    asm volatile("s_waitcnt vmcnt(0)" ::: "memory");
    __syncthreads();
    if (threadIdx.x == 0) {
        unsigned* bar = b.bar;
        __builtin_amdgcn_s_waitcnt(0);
        unsigned nloc = b.st[0], nx = b.st[1];
        if (nloc == 0u) { xcd_barrier_complete(bar, b.x, nloc, nx); b.st[0] = nloc; b.st[1] = nx; }
        const unsigned old = xb_add(&bar[XB_XSUB(b.x)], 1u);
        const unsigned gen = old / nloc;
        if (old + 1u == (gen + 1u) * nloc) {
            __builtin_amdgcn_fence(__ATOMIC_RELEASE, "agent");
            asm volatile("s_waitcnt vmcnt(0)" ::: "memory");
            const unsigned og = xb_add(&bar[XB_TOP], 1u);
            const unsigned tg = og / nx;
            if (og + 1u == (tg + 1u) * nx) xb_add(&bar[XB_TOPGEN], 1u);
            else XB_SPIN(xb_ld(&bar[XB_TOPGEN]) == tg, bar);
            __builtin_amdgcn_fence(__ATOMIC_ACQUIRE, "agent");
            xb_add(&bar[XB_XGEN(b.x)], 1u);
            asm volatile("s_waitcnt vmcnt(0)" ::: "memory");
        } else {
            XB_SPIN(xb_ld(&bar[XB_XGEN(b.x)]) == gen, bar);
            __builtin_amdgcn_fence(__ATOMIC_ACQUIRE, "agent");
            asm volatile("s_waitcnt vmcnt(0)" ::: "memory");
        }
    }
    __syncthreads();
}


__constant__ float ROPE_INV[16] = {1.0f, 0.44036659598350525f, 0.1939227432012558f, 0.08539710193872452f, 0.03760603070259094f, 0.01656043902039528f, 0.007292664609849453f, 0.0032114458736032248f,
    0.0014142135623842478f, 0.000622772378847003f, 0.00027424818836152554f, 0.00012076973507646471f, 5.318296098266728e-05f, 2.34199997066753e-05f, 1.0313386155758053e-05f, 4.541670477919979e-06f};

DI float wave_sum(float v) {
#pragma unroll
    for (int o = 32; o >= 1; o >>= 1) v += __shfl_xor(v, o);
    return v;
}
DI void rope_sincos(int pos, int i, float& sn, float& cs) {
    const float ang = (float)pos * ROPE_INV[i];
    const double a = (double)ang; const double k = __builtin_rint(a * 0.15915494309189535); const float r = (float)(a - k * 6.283185307179586);
    sn = __sinf(r); cs = __cosf(r);
}

DI void transpose_w(const float* __restrict__ W, bf16_t* __restrict__ Wt, int R, int C, int Cpad, LAS float* tile) {
    const int tid = TID(), bid = BID(), ntr = R / 64, ntc = Cpad / 64, ntiles = ntr * ntc;
    for (int t0 = bid * 4; t0 < ntiles; t0 += gridDim.x * 4) {
        float v[4][8];
#pragma unroll
        for (int u = 0; u < 4; ++u) { const int t = t0 + u; const int r0 = (t % ntr) * 64, c0 = (t / ntr) * 64;
#pragma unroll
            for (int i = 0; i < 8; ++i) { const int idx = tid + 512 * i, r = idx >> 6, c = idx & 63;
                v[u][i] = (t < ntiles && c0 + c < C) ? W[(size_t)(r0 + r) * C + c0 + c] : 0.f; } }
#pragma unroll
        for (int u = 0; u < 4; ++u)
#pragma unroll
            for (int i = 0; i < 8; ++i) { const int idx = tid + 512 * i, r = idx >> 6, c = idx & 63; tile[u * 4160 + c * 65 + r] = v[u][i]; }
        __syncthreads();
#pragma unroll
        for (int u = 0; u < 4; ++u) { const int t = t0 + u; if (t < ntiles) { const int r0 = (t % ntr) * 64, c0 = (t / ntr) * 64;
            const int c = tid >> 3, r8 = (tid & 7) * 8; const LAS float* p = tile + u * 4160 + c * 65 + r8;
            u32x4 w; w.x = cvt_pk_bf16(p[0], p[1]); w.y = cvt_pk_bf16(p[2], p[3]); w.z = cvt_pk_bf16(p[4], p[5]); w.w = cvt_pk_bf16(p[6], p[7]);
            *(u32x4*)(Wt + (size_t)(c0 + c) * R + r0 + r8) = w; } }
        __syncthreads();
    }
}
DI void convert_f32_bf16(const float* __restrict__ src, bf16_t* __restrict__ dst, size_t n) {
    const size_t nth = (size_t)gridDim.x * NTHREADS;
    const int tid = TID(), bid = BID();
    for (size_t i = ((size_t)bid * NTHREADS + tid) * 8; i < n; i += nth * 8) {
        const f32x4 a = *(const f32x4*)(src + i), b = *(const f32x4*)(src + i + 4);
        u32x4 w; w.x = cvt_pk_bf16(a[0], a[1]); w.y = cvt_pk_bf16(a[2], a[3]); w.z = cvt_pk_bf16(b[0], b[1]); w.w = cvt_pk_bf16(b[2], b[3]);
        *(u32x4*)(dst + i) = w; }
}
DI void pe_bias_partial(const float* __restrict__ kpe, const float* __restrict__ kw1, const float* __restrict__ vpe, const float* __restrict__ vw1, float* __restrict__ part, LAS float* red) {
    const int tid = TID(), bid = BID();
    for (int it = bid; it < 256; it += gridDim.x) {
        const int kv = it >> 7, cg8 = (it >> 4) & 7, ks = it & 15; const float* pe = kv ? vpe : kpe; const float* w1 = kv ? vw1 : kw1;
        const int n = cg8 * 64 + (tid & 63), sub = tid >> 6; float s = 0.f;
#pragma unroll 8
        for (int j = 0; j < 32; ++j) { const int k = ks * 256 + sub * 32 + j; s += pe[k] * w1[(size_t)k * 512 + n]; }
        red[tid] = s; __syncthreads();
        if (tid < 64) { float a = 0.f;
#pragma unroll
            for (int q = 0; q < 8; ++q) a += red[q * 64 + tid]; part[(kv * 16 + ks) * 512 + n] = a; }
        __syncthreads();
    }
}
DI void rmsnorm_bf16(const float* __restrict__ x, const float* __restrict__ g, bf16_t* __restrict__ out) {
    const int tid = TID(), bid = BID(); const int lane = tid & 63, gw = bid * 8 + (tid >> 6), nw = gridDim.x * 8;
    for (int row = gw; row < MT; row += nw) {
        const float* xr = x + (size_t)row * DM; f32x4 v[8]; float ss = 0.f;
#pragma unroll
        for (int k = 0; k < 8; ++k) { v[k] = *(const f32x4*)(xr + k * 256 + lane * 4); ss += v[k][0] * v[k][0] + v[k][1] * v[k][1] + v[k][2] * v[k][2] + v[k][3] * v[k][3]; }
        ss = wave_sum(ss); const float r = rsqrtf(ss * (1.f / DM) + 1e-6f);
#pragma unroll
        for (int k = 0; k < 8; ++k) { const f32x4 gk = *(const f32x4*)(g + k * 256 + lane * 4); u32x2 w; w.x = cvt_pk_bf16(v[k][0] * r * gk[0], v[k][1] * r * gk[1]); w.y = cvt_pk_bf16(v[k][2] * r * gk[2], v[k][3] * r * gk[3]);
            *(u32x2*)(out + (size_t)row * DM + k * 256 + lane * 4) = w; }
    }
}
DI void rmsnorm_f32_inplace(float* __restrict__ x, const float* __restrict__ g) {
    const int tid = TID(), bid = BID(); const int lane = tid & 63, gw = bid * 8 + (tid >> 6), nw = gridDim.x * 8;
    for (int row = gw; row < MT; row += nw) {
        float* xr = x + (size_t)row * DM; f32x4 v[8]; float ss = 0.f;
#pragma unroll
        for (int k = 0; k < 8; ++k) { v[k] = *(const f32x4*)(xr + k * 256 + lane * 4); ss += v[k][0] * v[k][0] + v[k][1] * v[k][1] + v[k][2] * v[k][2] + v[k][3] * v[k][3]; }
        ss = wave_sum(ss); const float r = rsqrtf(ss * (1.f / DM) + 1e-6f);
#pragma unroll
        for (int k = 0; k < 8; ++k) { const f32x4 gk = *(const f32x4*)(g + k * 256 + lane * 4); *(f32x4*)(xr + k * 256 + lane * 4) = v[k] * r * gk; }
    }
}

DI void gmlp_gate(const bf16_t* __restrict__ Z, const float* __restrict__ lng, const float* __restrict__ lnb, const float* __restrict__ gws, const float* __restrict__ gbs,
                  bf16_t* __restrict__ Hout, LAS unsigned char* lds) {
    LAS float* stat = (LAS float*)lds;
    LAS unsigned char* vt = lds + 1024;
    const int tid = TID(), bid = BID(), w = tid >> 6, lane = tid & 63, fr = lane & 15, fq = lane >> 4;
    for (int chunk = bid; chunk < MT / 128; chunk += gridDim.x) {
        const int tok0 = chunk * 128;
#pragma unroll 1
        for (int i0 = 0; i0 < 16; i0 += 4) { u32x4 q[4][4];
#pragma unroll
            for (int i = 0; i < 4; ++i)
#pragma unroll
                for (int k = 0; k < 4; ++k) q[i][k] = *(const u32x4*)(Z + (size_t)(tok0 + 16 * w + i0 + i) * 4096 + 2048 + (k * 64 + lane) * 8);
#pragma unroll
            for (int i = 0; i < 4; ++i) { const int s = 16 * w + i0 + i; float sm = 0.f, sq = 0.f;
#pragma unroll
                for (int k = 0; k < 4; ++k)
#pragma unroll
                    for (int e = 0; e < 4; ++e) { const float a = bflo(q[i][k][e]), b = bfhi(q[i][k][e]); sm += a + b; sq += a * a + b * b; }
                sm = wave_sum(sm); sq = wave_sum(sq); const float mean = sm * (1.f / 2048.f), var = sq * (1.f / 2048.f) - mean * mean;
                if (lane == 0) { stat[2 * s] = mean; stat[2 * s + 1] = rsqrtf(fmaxf(var, 0.f) + 1e-6f); } } }
        __syncthreads();
        const int t = 16 * w + fr, nks = (16 * w + 15) / 32 + 1, tok = tok0 + t;
        u32x4 vq[4]; u32x2 uq[8];
#define GM_LOADV(g_) do { _Pragma("unroll") for (int i_ = 0; i_ < 4; ++i_) { const int cid_ = tid + 512 * i_; vq[i_] = *(const u32x4*)(Z + (size_t)(tok0 + (cid_ >> 4)) * 4096 + 2048 + (g_) * 128 + (cid_ & 15) * 8); } } while (0)
#define GM_LOADU(g_) do { _Pragma("unroll") for (int dt_ = 0; dt_ < 8; ++dt_) uq[dt_] = *(const u32x2*)(Z + (size_t)tok * 4096 + (g_) * 128 + 16 * dt_ + 4 * fq); } while (0)
        GM_LOADV(0);
        for (int g = 0; g < 16; ++g) {
#pragma unroll
            for (int i = 0; i < 4; ++i) { const int cid = tid + 512 * i, s = cid >> 4, c8 = (cid & 15) * 8;
                const u32x4 q = vq[i]; const float mean = stat[2 * s], rstd = stat[2 * s + 1];
                const f32x4 g0 = *(const f32x4*)(lng + g * 128 + c8), g1 = *(const f32x4*)(lng + g * 128 + c8 + 4), b0 = *(const f32x4*)(lnb + g * 128 + c8), b1 = *(const f32x4*)(lnb + g * 128 + c8 + 4);
                float y[8];
#pragma unroll
                for (int e = 0; e < 4; ++e) { y[2 * e] = bflo(q[e]); y[2 * e + 1] = bfhi(q[e]); }
#pragma unroll
                for (int e = 0; e < 8; ++e) { const float gg = e < 4 ? g0[e & 3] : g1[e & 3], bb = e < 4 ? b0[e & 3] : b1[e & 3]; const float yn = (y[e] - mean) * rstd * gg + bb;
                    const int d = c8 + e; *(LAS bf16_t*)(vt + d * 256 + ((((s >> 3) ^ ((d >> 3) & 15)) << 4) | ((s & 7) << 1))) = f2bf(yn); } }
            GM_LOADU(g);
            if (g + 1 < 16) GM_LOADV(g + 1);
            __syncthreads();
            f32x4 acc[8];
#pragma unroll
            for (int dt = 0; dt < 8; ++dt) acc[dt] = (f32x4){0.f, 0.f, 0.f, 0.f};
            for (int ks = 0; ks < nks; ++ks) {
                const float* wp = gws + ((size_t)(g * 128 + t)) * 128 + ks * 32 + fq * 8; const f32x4 w0 = *(const f32x4*)wp, w1 = *(const f32x4*)(wp + 4); const int s0 = ks * 32 + fq * 8;
                float wv[8];
#pragma unroll
                for (int e = 0; e < 8; ++e) { const float x = e < 4 ? w0[e & 3] : w1[e & 3]; wv[e] = (s0 + e <= t) ? x : 0.f; }
                u32x4 wq; wq.x = cvt_pk_bf16(wv[0], wv[1]); wq.y = cvt_pk_bf16(wv[2], wv[3]); wq.z = cvt_pk_bf16(wv[4], wv[5]); wq.w = cvt_pk_bf16(wv[6], wv[7]);
                const bf16x8 wf = __builtin_bit_cast(bf16x8, wq);
#pragma unroll
                for (int dt = 0; dt < 8; ++dt) { const int d = 16 * dt + fr; const bf16x8 a = *(const LAS bf16x8*)(vt + d * 256 + (((ks * 4 + fq) ^ ((d >> 3) & 15)) << 4));
                    acc[dt] = __builtin_amdgcn_mfma_f32_16x16x32_bf16(a, wf, acc[dt], 0, 0, 0); }
            }
            { const float bias = gbs[g * 128 + t];
#pragma unroll
              for (int dt = 0; dt < 8; ++dt) { const int col = g * 128 + 16 * dt + 4 * fq; const u32x2 u2 = uq[dt];
                  u32x2 o; o.x = cvt_pk_bf16((acc[dt][0] + bias) * bflo(u2.x), (acc[dt][1] + bias) * bfhi(u2.x)); o.y = cvt_pk_bf16((acc[dt][2] + bias) * bflo(u2.y), (acc[dt][3] + bias) * bfhi(u2.y));
                  *(u32x2*)(Hout + (size_t)tok * DM + col) = o; } }
            __syncthreads();
        }
#undef GM_LOADV
#undef GM_LOADU
    }
}

DI void rope_qkv(bf16_t* __restrict__ QKV, int wg0, int nwg) {
    const int tid = TID(); const int b = BID() - wg0; if (b < 0 || b >= nwg) return;
    for (int idx = b * NTHREADS + tid; idx < MT * 16; idx += nwg * NTHREADS) {
        const int tok = idx >> 4, i = idx & 15; float sn, cs; rope_sincos(tok & (TT - 1), i, sn, cs);
        bf16_t* row = QKV + (size_t)tok * NQKV;
        bf16_t a1[24], a2[24];
#pragma unroll
        for (int h = 0; h < 24; ++h) { const int col = (h < 16 ? h * 128 : (h < 20 ? C_KS + (h - 16) * 128 : C_KW + (h - 20) * 128)) + i; a1[h] = row[col]; a2[h] = row[col + 16]; }
#pragma unroll
        for (int h = 0; h < 24; ++h) { const int col = (h < 16 ? h * 128 : (h < 20 ? C_KS + (h - 16) * 128 : C_KW + (h - 20) * 128)) + i;
            const float x1 = bf2f(a1[h]), x2 = bf2f(a2[h]); row[col] = f2bf(x1 * cs - x2 * sn); row[col + 16] = f2bf(x2 * cs + x1 * sn); }
    }
}
DI void transpose_v(const bf16_t* __restrict__ QKV, bf16_t* __restrict__ VSt, bf16_t* __restrict__ VWt, int wg0, int nwg, LAS unsigned char* lds) {
    const int blk = BID() - wg0; if (blk < 0 || blk >= nwg) return;
    const int tid = TID();
    for (int it = blk; it < 4096; it += nwg) {
        const int sel = it >> 11, bg = (it >> 8) & 7, tb = it & 255, b = bg >> 2, g = bg & 3;
        const bf16_t* src = QKV + (size_t)(b * TT + tb * 64) * NQKV + (sel ? C_VW : C_VS) + g * 128; bf16_t* dst = (sel ? VWt : VSt) + (size_t)bg * 128 * TT + tb * 64;
#pragma unroll
        for (int i = 0; i < 2; ++i) { const int cid = tid + 512 * i, t = cid >> 4, c8 = (cid & 15) * 8; *(LAS u32x4*)(lds + t * 272 + c8 * 2) = *(const u32x4*)(src + (size_t)t * NQKV + c8); }
        __syncthreads();
#pragma unroll
        for (int i = 0; i < 2; ++i) { const int cid = tid + 512 * i, d = cid >> 3, t8 = (cid & 7) * 8; unsigned short e[8];
#pragma unroll
            for (int k = 0; k < 8; ++k) e[k] = *(const LAS bf16_t*)(lds + (t8 + k) * 272 + d * 2);
            u32x4 w; w.x = e[0] | ((unsigned)e[1] << 16); w.y = e[2] | ((unsigned)e[3] << 16); w.z = e[4] | ((unsigned)e[5] << 16); w.w = e[6] | ((unsigned)e[7] << 16);
            *(u32x4*)(dst + (size_t)d * TT + t8) = w; }
        __syncthreads();
    }
}
DI void compress2(const bf16_t* __restrict__ HID, const bf16_t* __restrict__ W2t  , bf16_t* __restrict__ KC, bf16_t* __restrict__ VCt) {
    const int tid = TID(); const int lane = tid & 63, fr = lane & 15, fq = lane >> 4, gw = BID() * 8 + (tid >> 6), nw = gridDim.x * 8;
    for (int unit0 = gw; unit0 < 1024; unit0 += nw) {
        const int unit = __builtin_amdgcn_readfirstlane(unit0);
        const int r0 = unit * 16, kv = r0 >> 13, bg = (r0 >> 10) & 7, c0 = r0 & 1023;
        f32x4 acc[8];
#pragma unroll
        for (int nt = 0; nt < 8; ++nt) acc[nt] = (f32x4){0.f, 0.f, 0.f, 0.f};
        const bf16_t* ap = HID + (size_t)(r0 + fr) * 512 + fq * 8; const bf16_t* bp = W2t + (size_t)kv * 128 * 512 + (size_t)fr * 512 + fq * 8;
        if (kv == 0) {
#pragma unroll 2
            for (int ks = 0; ks < 16; ++ks) { const bf16x8 a = *(const bf16x8*)(ap + ks * 32); bf16x8 bq[8];
#pragma unroll
                for (int nt = 0; nt < 8; ++nt) bq[nt] = *(const bf16x8*)(bp + (size_t)nt * 16 * 512 + ks * 32);
                asm volatile("" : "+v"(bq[0]), "+v"(bq[1]), "+v"(bq[2]), "+v"(bq[3]), "+v"(bq[4]), "+v"(bq[5]), "+v"(bq[6]), "+v"(bq[7]));
#pragma unroll
                for (int nt = 0; nt < 8; ++nt) acc[nt] = __builtin_amdgcn_mfma_f32_16x16x32_bf16(bq[nt], a, acc[nt], 0, 0, 0); }
            const int c = c0 + fr; const bool dead = (c == 1023);
#pragma unroll
            for (int j = 0; j < 4; ++j) { float sn, cs; rope_sincos(16 * c + 31, 4 * fq + j, sn, cs); const float x1 = acc[0][j], x2 = acc[1][j]; acc[0][j] = x1 * cs - x2 * sn; acc[1][j] = x2 * cs + x1 * sn; }
#pragma unroll
            for (int nt = 0; nt < 8; ++nt) { u32x2 o; o.x = cvt_pk_bf16(acc[nt][0], acc[nt][1]); o.y = cvt_pk_bf16(acc[nt][2], acc[nt][3]); if (dead) { o.x = 0u; o.y = 0u; }
                *(u32x2*)(KC + ((size_t)bg * 1024 + c) * 128 + 16 * nt + 4 * fq) = o; }
        } else {
#pragma unroll 2
            for (int ks = 0; ks < 16; ++ks) { const bf16x8 a = *(const bf16x8*)(ap + ks * 32); bf16x8 bq[8];
#pragma unroll
                for (int nt = 0; nt < 8; ++nt) bq[nt] = *(const bf16x8*)(bp + (size_t)nt * 16 * 512 + ks * 32);
                asm volatile("" : "+v"(bq[0]), "+v"(bq[1]), "+v"(bq[2]), "+v"(bq[3]), "+v"(bq[4]), "+v"(bq[5]), "+v"(bq[6]), "+v"(bq[7]));
#pragma unroll
                for (int nt = 0; nt < 8; ++nt) acc[nt] = __builtin_amdgcn_mfma_f32_16x16x32_bf16(a, bq[nt], acc[nt], 0, 0, 0); }
#pragma unroll
            for (int nt = 0; nt < 8; ++nt) { const int c = c0 + 4 * fq; float v3 = acc[nt][3]; if (c + 3 == 1023) v3 = 0.f; u32x2 o; o.x = cvt_pk_bf16(acc[nt][0], acc[nt][1]); o.y = cvt_pk_bf16(acc[nt][2], v3);
                *(u32x2*)(VCt + ((size_t)bg * 128 + 16 * nt + fr) * 1024 + c) = o; }
        }
    }
}
namespace nsa {
constexpr int SLOT = 32768, VT_IN_SLOT = 16384, SEL_OFF = 131072, IMP_OFF = 0;
constexpr int ATT_LDS = 131072 + 2048;
constexpr float C2 = 0.08838834764831845f * 1.4426950408889634f;
constexpr float THR_RAW = 8.0f / C2;
struct SubState { float m[2], l[2], carry[2]; f32x4 o[2][8]; f32x4 la[2]; };

DI float xmax16(float x) { auto r = __builtin_amdgcn_permlane16_swap(__float_as_uint(x), __float_as_uint(x), false, false); return fmaxf(__uint_as_float(r[0]), __uint_as_float(r[1])); }
DI float xmax32(float x) { auto r = __builtin_amdgcn_permlane32_swap(__float_as_uint(x), __float_as_uint(x), false, false); return fmaxf(__uint_as_float(r[0]), __uint_as_float(r[1])); }
DI float xsum16(float x) { auto r = __builtin_amdgcn_permlane16_swap(__float_as_uint(x), __float_as_uint(x), false, false); return __uint_as_float(r[0]) + __uint_as_float(r[1]); }
DI float xsum32(float x) { auto r = __builtin_amdgcn_permlane32_swap(__float_as_uint(x), __float_as_uint(x), false, false); return __uint_as_float(r[0]) + __uint_as_float(r[1]); }
DI float quad_sum(float x) {
    x += __int_as_float(__builtin_amdgcn_update_dpp(0, __float_as_int(x), 0xB1, 0xF, 0xF, false));
    x += __int_as_float(__builtin_amdgcn_update_dpp(0, __float_as_int(x), 0x4E, 0xF, 0xF, false));
    return x;
}

DI unsigned wave_or(unsigned x) {
    x |= (unsigned)__builtin_amdgcn_update_dpp(0, (int)x, 0x128, 0xF, 0xF, false); x |= (unsigned)__builtin_amdgcn_update_dpp(0, (int)x, 0x124, 0xF, 0xF, false);
    x |= (unsigned)__builtin_amdgcn_update_dpp(0, (int)x, 0x122, 0xF, 0xF, false); x |= (unsigned)__builtin_amdgcn_update_dpp(0, (int)x, 0x121, 0xF, 0xF, false);
    { auto r = __builtin_amdgcn_permlane16_swap(x, x, false, false); x = r[0] | r[1]; }
    { auto r = __builtin_amdgcn_permlane32_swap(x, x, false, false); x = r[0] | r[1]; }
    return x;
}
#define NSA_DSR4(d0, d1, d2, d3, addr) asm volatile("ds_read_b128 %0, %4\n\tds_read_b128 %1, %4 offset:4096\n\tds_read_b128 %2, %4 offset:8192\n\tds_read_b128 %3, %4 offset:12288" \
        : "=&v"(d0), "=&v"(d1), "=&v"(d2), "=&v"(d3) : "v"(addr) : "memory")
#define NSA_WAIT4(n, a, b, c, d) asm volatile("s_waitcnt lgkmcnt(" #n ")" : "+v"(a), "+v"(b), "+v"(c), "+v"(d) :: "memory")
DI void qk_tile(f32x4 (&s)[4], const LAS unsigned char* sl, const int (&kra)[4], const bf16x8 (&qf)[4]) {
    const unsigned base = (unsigned)(size_t)sl;
    bf16x8 a0, a1, a2, a3, b0, b1, b2, b3; const f32x4 z = {0.f, 0.f, 0.f, 0.f};
    NSA_DSR4(a0, a1, a2, a3, base + kra[0]); NSA_DSR4(b0, b1, b2, b3, base + kra[1]);
    NSA_WAIT4(4, a0, a1, a2, a3);
    s[0] = __builtin_amdgcn_mfma_f32_16x16x32_bf16(a0, qf[0], z, 0, 0, 0); s[1] = __builtin_amdgcn_mfma_f32_16x16x32_bf16(a1, qf[0], z, 0, 0, 0);
    s[2] = __builtin_amdgcn_mfma_f32_16x16x32_bf16(a2, qf[0], z, 0, 0, 0); s[3] = __builtin_amdgcn_mfma_f32_16x16x32_bf16(a3, qf[0], z, 0, 0, 0);
    NSA_DSR4(a0, a1, a2, a3, base + kra[2]);
    NSA_WAIT4(4, b0, b1, b2, b3);
    s[0] = __builtin_amdgcn_mfma_f32_16x16x32_bf16(b0, qf[1], s[0], 0, 0, 0); s[1] = __builtin_amdgcn_mfma_f32_16x16x32_bf16(b1, qf[1], s[1], 0, 0, 0);
    s[2] = __builtin_amdgcn_mfma_f32_16x16x32_bf16(b2, qf[1], s[2], 0, 0, 0); s[3] = __builtin_amdgcn_mfma_f32_16x16x32_bf16(b3, qf[1], s[3], 0, 0, 0);
    NSA_DSR4(b0, b1, b2, b3, base + kra[3]);
    NSA_WAIT4(4, a0, a1, a2, a3);
    s[0] = __builtin_amdgcn_mfma_f32_16x16x32_bf16(a0, qf[2], s[0], 0, 0, 0); s[1] = __builtin_amdgcn_mfma_f32_16x16x32_bf16(a1, qf[2], s[1], 0, 0, 0);
    s[2] = __builtin_amdgcn_mfma_f32_16x16x32_bf16(a2, qf[2], s[2], 0, 0, 0); s[3] = __builtin_amdgcn_mfma_f32_16x16x32_bf16(a3, qf[2], s[3], 0, 0, 0);
    NSA_WAIT4(0, b0, b1, b2, b3);
    s[0] = __builtin_amdgcn_mfma_f32_16x16x32_bf16(b0, qf[3], s[0], 0, 0, 0); s[1] = __builtin_amdgcn_mfma_f32_16x16x32_bf16(b1, qf[3], s[1], 0, 0, 0);
    s[2] = __builtin_amdgcn_mfma_f32_16x16x32_bf16(b2, qf[3], s[2], 0, 0, 0); s[3] = __builtin_amdgcn_mfma_f32_16x16x32_bf16(b3, qf[3], s[3], 0, 0, 0);
}

#define NSA_DSR8(v, A0, A1, A2, A3, O0, O1) asm volatile( \
        "ds_read_b64 %0, %8 offset:%12\n\tds_read_b64 %1, %9 offset:%12\n\tds_read_b64 %2, %10 offset:%12\n\tds_read_b64 %3, %11 offset:%12\n\t" \
        "ds_read_b64 %4, %8 offset:%13\n\tds_read_b64 %5, %9 offset:%13\n\tds_read_b64 %6, %10 offset:%13\n\tds_read_b64 %7, %11 offset:%13" \
        : "=&v"(v[0]), "=&v"(v[1]), "=&v"(v[2]), "=&v"(v[3]), "=&v"(v[4]), "=&v"(v[5]), "=&v"(v[6]), "=&v"(v[7]) : "v"(A0), "v"(A1), "v"(A2), "v"(A3), "i"(O0), "i"(O1) : "memory")
#define NSA_WAIT8(n, v) asm volatile("s_waitcnt lgkmcnt(" #n ")" : "+v"(v[0]), "+v"(v[1]), "+v"(v[2]), "+v"(v[3]), "+v"(v[4]), "+v"(v[5]), "+v"(v[6]), "+v"(v[7]) :: "memory")
template <int AM>
DI void pv_tile(SubState& st, const bf16x8 (&pf)[2][2], const LAS unsigned char* sl, const int (&vra)[4]) {
    const unsigned base = (unsigned)(size_t)sl; const unsigned A0 = base + vra[0], A1 = base + vra[1], A2 = base + vra[2], A3 = base + vra[3];
    s16x4 va[8], vb[8];
#define PV_MMA(src, grp) do { _Pragma("unroll") for (int kk_ = 0; kk_ < 2; ++kk_) _Pragma("unroll") for (int d_ = 0; d_ < 2; ++d_) { \
        const bf16x8 vf_ = __builtin_shufflevector(src[d_ * 4 + kk_ * 2], src[d_ * 4 + kk_ * 2 + 1], 0, 1, 2, 3, 4, 5, 6, 7); \
        if (AM & 1) st.o[0][(grp) * 2 + d_] = __builtin_amdgcn_mfma_f32_16x16x32_bf16(vf_, pf[0][kk_], st.o[0][(grp) * 2 + d_], 0, 0, 0); \
        if (AM & 2) st.o[1][(grp) * 2 + d_] = __builtin_amdgcn_mfma_f32_16x16x32_bf16(vf_, pf[1][kk_], st.o[1][(grp) * 2 + d_], 0, 0, 0); } } while (0)
    NSA_DSR8(va, A0, A1, A2, A3, 0, 2048); NSA_DSR8(vb, A0, A1, A2, A3, 4096, 6144);
    NSA_WAIT8(8, va); PV_MMA(va, 0);
    NSA_DSR8(va, A0, A1, A2, A3, 8192, 10240);
    NSA_WAIT8(8, vb); PV_MMA(vb, 1);
    NSA_DSR8(vb, A0, A1, A2, A3, 12288, 14336);
    NSA_WAIT8(8, va); PV_MMA(va, 2);
    NSA_WAIT8(0, vb); PV_MMA(vb, 3);
#undef PV_MMA
}

template <int BR>
DI void run_branch(const bf16_t* __restrict__ Ksrc, size_t kstride, const bf16_t* __restrict__ Vsrc, size_t vstride, int tile_lo, int ntiles,
                   const bf16x8 (&q)[2][4], SubState& st, int t0, int qb, const int (&tokl)[2], LAS unsigned char* lds) {
    constexpr bool WITHV = (BR != 0);
    constexpr int TPR = (BR != 1) ? 2 : 1, RING0 = (BR != 1) ? 0 : 2 * SLOT;
    const int tid = TID(), w = __builtin_amdgcn_readfirstlane(tid >> 6), lane = tid & 63, fr = lane & 15, fq = lane >> 4;
    LAS float* IMP = (LAS float*)(lds + IMP_OFF); LAS unsigned* SEL = (LAS unsigned*)(lds + SEL_OFF);
    unsigned kof[2], vof[2];
#pragma unroll
    for (int i = 0; i < 2; ++i) { const int row = (i * 8 + w) * 4 + (lane >> 4), ch = (lane & 15) ^ (row & 15); kof[i] = (unsigned)row * (unsigned)kstride + ch * 8;
        const int dim = (i * 8 + w) * 8 + (lane >> 3), cv = (lane & 7) ^ ((dim >> 1) & 7); vof[i] = (unsigned)dim * (unsigned)vstride + cv * 8; }
    int kra[4], vra[4];
#pragma unroll
    for (int ks = 0; ks < 4; ++ks) kra[ks] = fr * 256 + (((ks * 4 + fq) ^ (fr & 15)) << 4);
#pragma unroll
    for (int c = 0; c < 4; ++c) vra[c] = VT_IN_SLOT + fr * 128 + ((((c << 1) | (fq >> 1)) ^ ((fr >> 1) & 7)) << 4) + (fq & 1) * 8;
#define NSA_ISSUE(rr, bb) do { _Pragma("unroll") for (int u_ = 0; u_ < TPR; ++u_) { const int t_ = (rr) * TPR + u_; if (t_ < ntiles) { const int tile_ = tile_lo + t_; \
        LAS unsigned char* sl_ = lds + RING0 + ((bb) * TPR + u_) * SLOT; const bf16_t* kb_ = Ksrc + (size_t)tile_ * 64 * kstride; const bf16_t* vb_ = Vsrc + (size_t)tile_ * 64; \
        _Pragma("unroll") for (int i_ = 0; i_ < 2; ++i_) { \
            __builtin_amdgcn_global_load_lds((const unsigned*)(kb_ + kof[i_]), (LAS unsigned*)(sl_ + (i_ * 8 + w) * 1024), 16, 0, 0); \
            if (WITHV) __builtin_amdgcn_global_load_lds((const unsigned*)(vb_ + vof[i_]), (LAS unsigned*)(sl_ + VT_IN_SLOT + (i_ * 8 + w) * 1024), 16, 0, 0); } } } } while (0)
    const int nr = (ntiles + TPR - 1) / TPR;
    __syncthreads();
    NSA_ISSUE(0, 0);
    for (int r = 0; r < nr; ++r) {
        asm volatile("s_waitcnt vmcnt(0)" ::: "memory");
        __syncthreads();
        if (r + 1 < nr) NSA_ISSUE(r + 1, (r + 1) & 1);
#pragma unroll
        for (int u = 0; u < TPR; ++u) {
            const int t = r * TPR + u; if (t >= ntiles) break;
            const int tile = tile_lo + t, k0 = tile * 64;
            const LAS unsigned char* sl = lds + RING0 + ((r & 1) * TPR + u) * SLOT;
            bool act[2] = {true, true}; bool selbit[2] = {true, true};
            if (BR == 2) {
#pragma unroll
                for (int sb = 0; sb < 2; ++sb) { selbit[sb] = ((SEL[tokl[sb] * 8 + (tile >> 5)] >> (tile & 31)) & 1u) != 0u; act[sb] = __any(selbit[sb]) != 0; }
                if (!act[0] && !act[1]) continue;
            }
            bool need_mask;
            if (BR <= 1) need_mask = (k0 + 63) > ((t0 - 31) >> 4);
            else if (BR == 2) need_mask = (tile == qb);
            else need_mask = (tile == qb) || (tile == qb - 8);
            bf16x8 pf[2][2];
#pragma unroll
            for (int sb = 0; sb < 2; ++sb) {
                if (!act[sb]) continue;
                f32x4 s[4];
                qk_tile(s, sl, kra, q[sb]);
                if (need_mask) {
                    const int tok = t0 + tokl[sb]; const int kb = k0 + 4 * fq;
#pragma unroll
                    for (int kt = 0; kt < 4; ++kt)
#pragma unroll
                        for (int j = 0; j < 4; ++j) { const int key = kb + 16 * kt + j; bool valid;
                            if (BR <= 1) valid = key <= ((tok - 31) >> 4);
                            else if (BR == 2) valid = key <= tok;
                            else valid = key <= tok && key > tok - 512;
                            s[kt][j] = valid ? s[kt][j] : -__builtin_inff(); }
                }
                if (BR == 0) {
                    float mx = fmaxf(fmaxf(s[0][0], s[0][1]), fmaxf(s[0][2], s[0][3]));
#pragma unroll
                    for (int kt = 1; kt < 4; ++kt) mx = fmaxf(mx, fmaxf(fmaxf(s[kt][0], s[kt][1]), fmaxf(s[kt][2], s[kt][3])));
                    const float mn = fmaxf(st.m[sb], mx), mc0 = -mn * C2; float sum = 0.f;
#pragma unroll
                    for (int kt = 0; kt < 4; ++kt)
#pragma unroll
                        for (int j = 0; j < 4; ++j) sum += __builtin_amdgcn_exp2f(__builtin_fmaf(s[kt][j], C2, mc0));
                    st.l[sb] = st.l[sb] * __builtin_amdgcn_exp2f((st.m[sb] - mn) * C2) + sum; st.m[sb] = mn;
                    continue;
                }
                if (BR == 1) {
                    const float mc1 = -st.m[sb] * C2, il = st.l[sb];
#pragma unroll
                    for (int kt = 0; kt < 4; ++kt)
#pragma unroll
                        for (int j = 0; j < 4; ++j) s[kt][j] = __builtin_amdgcn_exp2f(__builtin_fmaf(s[kt][j], C2, mc1)) * il;
                    float prev = st.carry[sb];
#pragma unroll
                    for (int kt = 0; kt < 4; ++kt) { const float a = quad_sum(2.f * (s[kt][0] + s[kt][1] + s[kt][2]) + s[kt][3]), c3 = quad_sum(s[kt][3]);
                        const float rot = __shfl(c3, (lane - 16) & 63); const float recv = (fq == 0) ? prev : rot; prev = rot;
                        if ((fr & 3) == 0) IMP[tokl[sb] * 256 + (k0 >> 2) + 4 * kt + fq] = a + recv; }
                    st.carry[sb] = prev;
                } else {
                    float mx = fmaxf(fmaxf(s[0][0], s[0][1]), fmaxf(s[0][2], s[0][3]));
#pragma unroll
                    for (int kt = 1; kt < 4; ++kt) mx = fmaxf(mx, fmaxf(fmaxf(s[kt][0], s[kt][1]), fmaxf(s[kt][2], s[kt][3])));
                    if (BR == 2) mx = selbit[sb] ? mx : -__builtin_inff();
                    mx = xmax32(xmax16(mx));
                    if (!__all(mx - st.m[sb] <= THR_RAW)) {
                        const float mn = fmaxf(st.m[sb], mx), alpha = __builtin_amdgcn_exp2f((st.m[sb] - mn) * C2); st.m[sb] = mn; st.la[sb] *= alpha;
#pragma unroll
                        for (int dt = 0; dt < 8; ++dt) st.o[sb][dt] *= alpha;
                    }
                    float mrow = st.m[sb]; if (BR == 2) mrow = selbit[sb] ? mrow : __builtin_inff();
                    const float mc2 = -mrow * C2;
#pragma unroll
                    for (int kt = 0; kt < 4; ++kt)
#pragma unroll
                        for (int j = 0; j < 4; ++j) s[kt][j] = __builtin_amdgcn_exp2f(__builtin_fmaf(s[kt][j], C2, mc2));
                }
#pragma unroll
                for (int kk = 0; kk < 2; ++kk) { u32x4 wq; wq.x = cvt_pk_bf16(s[2 * kk][0], s[2 * kk][1]); wq.y = cvt_pk_bf16(s[2 * kk][2], s[2 * kk][3]); wq.z = cvt_pk_bf16(s[2 * kk + 1][0], s[2 * kk + 1][1]); wq.w = cvt_pk_bf16(s[2 * kk + 1][2], s[2 * kk + 1][3]);
                    pf[sb][kk] = __builtin_bit_cast(bf16x8, wq); }
                if (BR >= 2) { const bf16x8 ones = (bf16x8){0x3f80, 0x3f80, 0x3f80, 0x3f80, 0x3f80, 0x3f80, 0x3f80, 0x3f80};
                    st.la[sb] = __builtin_amdgcn_mfma_f32_16x16x32_bf16(ones, pf[sb][0], st.la[sb], 0, 0, 0); st.la[sb] = __builtin_amdgcn_mfma_f32_16x16x32_bf16(ones, pf[sb][1], st.la[sb], 0, 0, 0); }
                if (BR == 2) { if (sb == 0) pv_tile<1>(st, pf, sl, vra); else pv_tile<2>(st, pf, sl, vra); }
            }
            if (BR == 1 || BR == 3) pv_tile<3>(st, pf, sl, vra);
        }
    }
#undef NSA_ISSUE
}

template <bool FIRST, bool NORMALIZE>
DI void branch_out(SubState& st, const float (&gl)[2], bf16_t* __restrict__ O, int tokg0, const int (&tokl)[2], int head, int fq) {
#pragma unroll
    for (int sb = 0; sb < 2; ++sb) {
        float f = 1.f;
        if (NORMALIZE) { const float l = st.la[sb][0]; f = l > 0.f ? 1.f / l : 0.f; }
        const size_t tok = (size_t)(tokg0 + tokl[sb]);
        f *= sigmoidf_(gl[sb]);
        bf16_t* op = O + tok * DM + head * 128 + 4 * fq;
        u32x2 oldv[8];
        if (!FIRST) {
#pragma unroll
            for (int dt = 0; dt < 8; ++dt) oldv[dt] = *(const u32x2*)(op + 16 * dt); }
#pragma unroll
        for (int dt = 0; dt < 8; ++dt) { f32x4 v = st.o[sb][dt] * f;
            if (!FIRST) { const u32x2 old = oldv[dt]; v[0] += bflo(old.x); v[1] += bfhi(old.x); v[2] += bflo(old.y); v[3] += bfhi(old.y); }
            u32x2 w; w.x = cvt_pk_bf16(v[0], v[1]); w.y = cvt_pk_bf16(v[2], v[3]); *(u32x2*)(op + 16 * dt) = w; }
    }
}
DI void reset_state(SubState& st) {
#pragma unroll
    for (int sb = 0; sb < 2; ++sb) { st.m[sb] = -1e30f; st.l[sb] = 0.f; st.carry[sb] = 0.f; st.la[sb] = (f32x4){0.f, 0.f, 0.f, 0.f};
#pragma unroll
        for (int dt = 0; dt < 8; ++dt) st.o[sb][dt] = (f32x4){0.f, 0.f, 0.f, 0.f}; }
}

DI void attn_phase(const bf16_t* __restrict__ QKV, const bf16_t* __restrict__ KC, const bf16_t* __restrict__ VCt, const bf16_t* __restrict__ VSt, const bf16_t* __restrict__ VWt,
                   bf16_t* __restrict__ O, LAS unsigned char* lds, unsigned* __restrict__ qctr) {
    const int tid = TID(), bid = BID(), w = tid >> 6, lane = tid & 63, fr = lane & 15, fq = lane >> 4;
    LAS float* IMP = (LAS float*)(lds + IMP_OFF); LAS unsigned* SEL = (LAS unsigned*)(lds + SEL_OFF);
    volatile LAS unsigned* bcast = (volatile LAS unsigned*)(lds + BARST_OFF + 8);
    const int bg = bid & 7, b = bg >> 2, g = bg & 3;
    for (;;) {
        __syncthreads();
        if (tid == 0) *bcast = __hip_atomic_fetch_add(qctr + bg * 16, 1u, __ATOMIC_RELAXED, __HIP_MEMORY_SCOPE_AGENT);
        __syncthreads();
        const int it = (int)*bcast; if (it >= 256) break;
        const int qb = 255 - it;
        const int t0 = qb * 64, tokg0 = b * TT + t0, head = g * 4 + (fr & 3);
        const int tokl[2] = {8 * w + (fr >> 2), 8 * w + 4 + (fr >> 2)};
        bf16x8 q[2][4];
#pragma unroll
        for (int sb = 0; sb < 2; ++sb)
#pragma unroll
            for (int ks = 0; ks < 4; ++ks) q[sb][ks] = *(const bf16x8*)(QKV + (size_t)(tokg0 + tokl[sb]) * NQKV + head * 128 + ks * 32 + fq * 8);
        float gatev[3][2];
#pragma unroll
        for (int br = 0; br < 3; ++br)
#pragma unroll
            for (int sb = 0; sb < 2; ++sb) gatev[br][sb] = bf2f(QKV[(size_t)(tokg0 + tokl[sb]) * NQKV + C_GL + br * 16 + head]);
        SubState st;
        const int ntc = ((4 * qb + 2) >> 6) + 1;
        const bf16_t* kc = KC + (size_t)bg * 1024 * 128; const bf16_t* vc = VCt + (size_t)bg * 128 * 1024;
        reset_state(st);
        run_branch<0>(kc, 128, vc, 1024, 0, ntc, q, st, t0, qb, tokl, lds);
#pragma unroll
        for (int sb = 0; sb < 2; ++sb) { const float m = xmax32(xmax16(st.m[sb]));
            const float l = xsum32(xsum16(st.l[sb] * __builtin_amdgcn_exp2f((st.m[sb] - m) * C2)));
            st.m[sb] = m; st.l[sb] = l > 0.f ? 1.f / l : 0.f; }
        run_branch<1>(kc, 128, vc, 1024, 0, ntc, q, st, t0, qb, tokl, lds);
        branch_out<true, false>(st, gatev[0], O, tokg0, tokl, head, fq);
        {
            const int ncand = qb - 2 > 0 ? qb - 2 : 0, Kc = 16 - (qb + 1 < 3 ? qb + 1 : 3);
#pragma unroll 1
            for (int x0 = 0; x0 < 8; x0 += 4) {
                unsigned key[4][4]; bool sel[4][4];
#pragma unroll
                for (int x = 0; x < 4; ++x)
#pragma unroll
                    for (int kk = 0; kk < 4; ++kk) { const int s = kk * 64 + lane; const bool cand = (s >= 1 && s <= qb - 2); key[x][kk] = cand ? (__float_as_uint(IMP[(8 * w + x0 + x) * 256 + s]) + 1u) : 0u; }
                if (ncand <= Kc) {
#pragma unroll
                    for (int x = 0; x < 4; ++x)
#pragma unroll
                        for (int kk = 0; kk < 4; ++kk) sel[x][kk] = key[x][kk] != 0u;
                } else {
                    unsigned prefix[4]; bool done[4] = {false, false, false, false}; int hb[4]; int hmax = -1;
#pragma unroll
                    for (int x = 0; x < 4; ++x) {
                        unsigned ko = 0u, kna = 0u;
#pragma unroll
                        for (int kk = 0; kk < 4; ++kk) { ko |= key[x][kk]; kna |= key[x][kk] ? ~key[x][kk] : 0u; }
                        ko = (unsigned)__builtin_amdgcn_readfirstlane((int)wave_or(ko)); kna = (unsigned)__builtin_amdgcn_readfirstlane((int)wave_or(kna));
                        const unsigned diff = ko & kna;
                        hb[x] = diff ? 31 - __builtin_clz(diff) : -1;
                        prefix[x] = hb[x] >= 31 ? 0u : (ko & ~((2u << (hb[x] < 0 ? 0 : hb[x])) - 1u));
                        if (hb[x] < 0) { prefix[x] = ko; done[x] = true; }
                        hmax = hb[x] > hmax ? hb[x] : hmax; }
                    for (int bit = hmax; bit >= 0; --bit) {
#pragma unroll
                        for (int x = 0; x < 4; ++x) { if (done[x] || bit > hb[x]) continue; const unsigned trial = prefix[x] | (1u << bit); int cnt = 0;
#pragma unroll
                            for (int kk = 0; kk < 4; ++kk) cnt += __popcll(__ballot(key[x][kk] >= trial));
                            if (cnt >= Kc) prefix[x] = trial;
                            if (cnt == Kc) done[x] = true; }
                        if (done[0] && done[1] && done[2] && done[3]) break; }
#pragma unroll
                    for (int x = 0; x < 4; ++x) { int ngt = 0;
#pragma unroll
                        for (int kk = 0; kk < 4; ++kk) ngt += __popcll(__ballot(key[x][kk] > prefix[x]));
                        int need = Kc - ngt;
#pragma unroll
                        for (int kk = 0; kk < 4; ++kk) { const bool eq = key[x][kk] == prefix[x]; const unsigned long long bal = __ballot(eq); const int rank = __popcll(bal & ((1ull << lane) - 1ull));
                            sel[x][kk] = key[x][kk] > prefix[x] || (eq && rank < need); const int tot = __popcll(bal); need -= (tot < need ? tot : need); } }
                }
#pragma unroll
                for (int x = 0; x < 4; ++x)
#pragma unroll
                    for (int kk = 0; kk < 4; ++kk) { const int s = kk * 64 + lane; const bool fs = sel[x][kk] || s == 0 || s == qb || s == qb - 1; const unsigned long long bal = __ballot(fs);
                        if (lane == 0) { SEL[(8 * w + x0 + x) * 8 + 2 * kk] = (unsigned)bal; SEL[(8 * w + x0 + x) * 8 + 2 * kk + 1] = (unsigned)(bal >> 32); } }
            }
        }
        reset_state(st);
        run_branch<2>(QKV + (size_t)(b * TT) * NQKV + C_KS + g * 128, NQKV, VSt + (size_t)bg * 128 * TT, TT, 0, qb + 1, q, st, t0, qb, tokl, lds);
        branch_out<false, true>(st, gatev[1], O, tokg0, tokl, head, fq);
        reset_state(st);
        { const int lo = qb - 8 > 0 ? qb - 8 : 0;
          run_branch<3>(QKV + (size_t)(b * TT) * NQKV + C_KW + g * 128, NQKV, VWt + (size_t)bg * 128 * TT, TT, lo, qb - lo + 1, q, st, t0, qb, tokl, lds); }
        branch_out<false, true>(st, gatev[2], O, tokg0, tokl, head, fq);
    }
}
}
constexpr size_t WS_WUP = 0, WS_WDN = 67108864, WS_WGATE = 134217728, WS_WPLE = 150994944, WS_WGIN = 153092096, WS_WGOUT = 169869312, WS_WNIN = 178257920, WS_WNOUT = 200278016,
                 WS_WC1 = 208666624, WS_WC2 = 217055232, WS_PBF = 217317376, WS_BIASP = 250871808, WS_BIAS = 250937344, WS_H = 250941440, WS_HB = 385159168, WS_S1 = 519376896,
                 WS_VST = 896864256, WS_VWT = 930418688, WS_HID = 963973120, WS_KC = 980750336, WS_VCT = 982847488,
                 WS_PARTA = 1056247808, WS_PARTB = 1060442112, WS_BAR = 1064636416, WS_END = 1064636416 + 16384;

struct Params {
    const float* x; const float* p; const float* norm_mix; const float* norm_ffn; const float* norm_ple; const float* ffn_up; const float* ffn_down; const float* ple_proj; const float* ple_gate;
    const float* gm_in; const float* gm_ln_g; const float* gm_ln_b; const float* gm_ws; const float* gm_bs; const float* gm_out;
    const float* nsa_in; const float* kc_pe; const float* kc_w1; const float* kc_w2; const float* vc_pe; const float* vc_w1; const float* vc_w2; const float* nsa_out; const float* final_norm;
    float* out; unsigned char* ws;
};

DI pg8::Gemm<0> mkgemm(const void* A, unsigned lda_bytes, const void* Bt, int N, int K) {
    pg8::Gemm<0> g; g.A = (const char*)A; g.Bt = (const char*)Bt; g.M = MT; g.N = N; g.nt = K / 64; g.lda = lda_bytes; g.ldb = (unsigned)K * 2u; g.kstep2 = 256u; return g;
}

__global__ void __launch_bounds__(NTHREADS, 2) mega(Params Parg) {
    extern __shared__ __attribute__((aligned(16))) unsigned char lds_raw[];
    LAS unsigned char* lds = (LAS unsigned char*)lds_raw;
    cg::grid_group grid = cg::this_grid();
    typedef const __attribute__((address_space(4))) Params* KP;
    const int G = gridDim.x;
    volatile LAS unsigned* barst = (volatile LAS unsigned*)(lds + BARST_OFF);
    if (threadIdx.x < 4) barst[threadIdx.x] = 0u;
    __syncthreads();
    (void)xcd_barrier_post((unsigned*)(Parg.ws + WS_BAR), barst);
    for (int step = 0; step <= 15; ++step) {
        const int ph = step < 12 ? step : (step < 15 ? step - 8 : 12), l = step >= 12 ? 1 : 0;
        KP Pk = (KP)__builtin_amdgcn_kernarg_segment_ptr(); asm volatile("" : "+s"(Pk));
#define P (*Pk)
        unsigned char* ws = P.ws;
        bf16_t* Wup = (bf16_t*)(ws + WS_WUP); bf16_t* Wdn = (bf16_t*)(ws + WS_WDN); bf16_t* Wgate = (bf16_t*)(ws + WS_WGATE); bf16_t* Wple = (bf16_t*)(ws + WS_WPLE);
        bf16_t* Wgin = (bf16_t*)(ws + WS_WGIN); bf16_t* Wgout = (bf16_t*)(ws + WS_WGOUT); bf16_t* Wnin = (bf16_t*)(ws + WS_WNIN); bf16_t* Wnout = (bf16_t*)(ws + WS_WNOUT);
        bf16_t* Wc1 = (bf16_t*)(ws + WS_WC1); bf16_t* Wc2 = (bf16_t*)(ws + WS_WC2); bf16_t* Pbf = (bf16_t*)(ws + WS_PBF); float* biasp = (float*)(ws + WS_BIASP); float* bias = (float*)(ws + WS_BIAS);
        bf16_t* H = (bf16_t*)(ws + WS_H); bf16_t* Hb = (bf16_t*)(ws + WS_HB); float* partA = (float*)(ws + WS_PARTA); float* partB = (float*)(ws + WS_PARTB); bf16_t* S1 = (bf16_t*)(ws + WS_S1);
        bf16_t* VSt = (bf16_t*)(ws + WS_VST); bf16_t* VWt = (bf16_t*)(ws + WS_VWT);
        bf16_t* HID = (bf16_t*)(ws + WS_HID); bf16_t* KC = (bf16_t*)(ws + WS_KC); bf16_t* VCt = (bf16_t*)(ws + WS_VCT);
        const int bid = BID();
        pg8::StaticOrder SO;
        switch (ph) {
        case 0: {
            LAS float* tile = (LAS float*)lds;
            for (int ll = 0; ll < 2; ++ll) {
                transpose_w(P.ffn_up + (size_t)ll * DM * DFF, Wup + (size_t)ll * DFF * DM, DM, DFF, DFF, tile);
                transpose_w(P.ffn_down + (size_t)ll * DFF * DM, Wdn + (size_t)ll * DM * DFF, DFF, DM, DM, tile);
                transpose_w(P.ple_gate + (size_t)ll * DM * DM, Wgate + (size_t)ll * DM * DM, DM, DM, DM, tile);
                transpose_w(P.ple_proj + (size_t)ll * PLE * DM, Wple + (size_t)ll * DM * PLE, PLE, DM, DM, tile);
            }
            transpose_w(P.gm_in, Wgin, DM, 4096, 4096, tile);
            transpose_w(P.gm_out, Wgout, DM, DM, DM, tile);
            transpose_w(P.nsa_in, Wnin, DM, NQKV_REAL, NQKV, tile);
            transpose_w(P.nsa_out, Wnout, DM, DM, DM, tile);
            transpose_w(P.kc_w1, Wc1, 4096, 512, 512, tile);
            transpose_w(P.vc_w1, Wc1 + (size_t)512 * 4096, 4096, 512, 512, tile);
            transpose_w(P.kc_w2, Wc2, 512, 128, 128, tile);
            transpose_w(P.vc_w2, Wc2 + (size_t)128 * 512, 512, 128, 128, tile);
            convert_f32_bf16(P.p, Pbf, (size_t)2 * MT * PLE);
            pe_bias_partial(P.kc_pe, P.kc_w1, P.vc_pe, P.vc_w1, biasp, tile);
            rmsnorm_bf16(P.x, P.norm_mix, H);
        } break;
        case 1: { auto g = mkgemm(H, DM * 2, Wgin, 4096, DM); SO.init(MT, 4096, G, bid); pg8::EpiAct<1, false> E{S1, 4096, nullptr, nullptr}; pg8::gemm_phase(lds, g, SO, E); } break;
        case 2: gmlp_gate(S1, P.gm_ln_g, P.gm_ln_b, P.gm_ws, P.gm_bs, H, lds); break;
        case 3: { auto g = mkgemm(H, DM * 2, Wgout, DM, DM); SO.init(MT, DM, G, bid); pg8::EpiResN<false> E{P.x, P.out, nullptr, nullptr, P.norm_ffn, Hb, partA}; pg8::gemm_phase(lds, g, SO, E); } break;
        case 4: { auto g = mkgemm(Hb, DM * 2, Wup + (size_t)l * DFF * DM, DFF, DM); SO.init(MT, DFF, G, bid); pg8::EpiAct<2, false> E{S1, DFF, nullptr, partA}; pg8::gemm_phase(lds, g, SO, E); } break;
        case 5: { { auto g = mkgemm(S1, DFF * 2, Wdn + (size_t)l * DM * DFF, DM, DFF); SO.init(MT, DM, G, bid); pg8::EpiResN<false> E{P.out, P.out, nullptr, nullptr, P.norm_ple + l * DM, H, partB}; pg8::gemm_phase(lds, g, SO, E); }
                  { auto g = mkgemm(Pbf + (size_t)l * MT * PLE, PLE * 2, Wple + (size_t)l * DM * PLE, DM, PLE); SO.init(MT, DM, G, bid); pg8::EpiAct<0, false> E{Hb, DM, nullptr, nullptr}; pg8::gemm_phase(lds, g, SO, E); } } break;
        case 6: { auto g = mkgemm(H, DM * 2, Wgate + (size_t)l * DM * DM, DM, DM); SO.init(MT, DM, G, bid);
                  pg8::EpiResN<true> E{P.out, P.out, Hb, partB, P.norm_mix + DM, l == 0 ? Hb : nullptr, partA}; pg8::gemm_phase(lds, g, SO, E); } break;
        case 7: { { const int t = bid * NTHREADS + TID(); if (t < 1024) { const int kv = t >> 9, n = t & 511; float pv[16];
#pragma unroll
                      for (int ks = 0; ks < 16; ++ks) pv[ks] = biasp[(kv * 16 + ks) * 512 + n];
                      float a = 0.f;
#pragma unroll
                      for (int ks = 0; ks < 16; ++ks) a += pv[ks];
                      bias[t] = a; } }
                  auto g = mkgemm(Hb, DM * 2, Wnin, NQKV, DM); SO.init(MT, NQKV, G, bid); pg8::EpiAct<0, false> E{S1, NQKV, nullptr, partA}; pg8::gemm_phase(lds, g, SO, E); } break;
        case 8: { pg8::Gemm<1> g; g.A = (const char*)S1; g.Bt = (const char*)Wc1; g.M = 16384; g.N = 512; g.nt = 64; g.lda = 16u * NQKV * 2u; g.ldb = 4096u * 2u; g.kstep2 = NQKV * 2u;
                   SO.init(16384, 512, G, bid); pg8::EpiAct<1, true> E{HID, 512, bias, nullptr}; pg8::gemm_phase(lds, g, SO, E);
                   rope_qkv(S1, 128, G - 128); transpose_v(S1, VSt, VWt, 128, G - 128, lds); } break;
        case 9: compress2(HID, Wc2, KC, VCt); break;
        case 10: nsa::attn_phase(S1, KC, VCt, VSt, VWt, H, lds, (unsigned*)(ws + WS_BAR + 14336)); break;
        case 11: { auto g = mkgemm(H, DM * 2, Wnout, DM, DM); SO.init(MT, DM, G, bid); pg8::EpiResN<false> E{P.out, P.out, nullptr, nullptr, P.norm_ffn + DM, Hb, partA}; pg8::gemm_phase(lds, g, SO, E); } break;
        default: rmsnorm_f32_inplace(P.out, P.final_norm); break;
        }
        if (step < 15) { if (step == 0) grid.sync(); else { XcdBarrier xb; xb.bar = (unsigned*)(ws + WS_BAR); xb.x = xb_xcc_id(); xb.st = (volatile LAS unsigned*)(lds + BARST_OFF); xcd_barrier(xb); } }
#undef P
    }
}

extern "C" void kernel_launch(void* const* d_in, const int* in_sizes, int n_in, void* d_out, int out_size, void* d_ws, size_t ws_size, hipStream_t stream) {
    static int grid = 0;
    if (!grid) {
        int dev = 0, cus = 0, per_cu = 0; (void)hipGetDevice(&dev);
        (void)hipDeviceGetAttribute(&cus, hipDeviceAttributeMultiprocessorCount, dev);
        (void)hipFuncSetAttribute((const void*)mega, hipFuncAttributeMaxDynamicSharedMemorySize, LDS_BYTES);
        (void)hipOccupancyMaxActiveBlocksPerMultiprocessor(&per_cu, (const void*)mega, NTHREADS, LDS_BYTES);
        if (per_cu < 1) per_cu = 1;
        grid = cus * per_cu;
        if (n_in != 24 || ws_size < WS_END) fprintf(stderr, "kernel_launch: unexpected n_in %d / ws_size %zu\n", n_in, ws_size);
    }
    (void)hipMemsetAsync((unsigned char*)d_ws + WS_BAR, 0, 16384, stream);
    Params P{};
    const float** pp = (const float**)&P;
    for (int i = 0; i < 24; ++i) pp[i] = (const float*)d_in[i];
    P.out = (float*)d_out; P.ws = (unsigned char*)d_ws;
    void* args[] = {&P};
    hipError_t e = hipLaunchCooperativeKernel((void*)mega, dim3(grid), dim3(NTHREADS), args, LDS_BYTES, stream);
    if (e != hipSuccess) fprintf(stderr, "cooperative launch failed: %s (grid %d)\n", hipGetErrorString(e), grid);
}
```

```cpp
#include <hip/hip_runtime.h>
#include <hip/hip_cooperative_groups.h>
#include <cstdio>
#include <cstdint>
namespace cg = cooperative_groups;

#define LAS __attribute__((address_space(3)))
#define DI __device__ __forceinline__
typedef unsigned short bf16_t;
typedef short bf16x8 __attribute__((ext_vector_type(8)));
typedef short s16x4 __attribute__((ext_vector_type(4)));
typedef float f32x4 __attribute__((ext_vector_type(4)));
typedef float f32x2 __attribute__((ext_vector_type(2)));
typedef unsigned u32x4 __attribute__((ext_vector_type(4)));
typedef unsigned u32x2 __attribute__((ext_vector_type(2)));

constexpr int MT = 32768, TT = 16384, DM = 2048, DFF = 8192, PLE = 256;
constexpr int NQKV = 5376, NQKV_REAL = 5168;
constexpr int C_Q = 0, C_KC = 2048, C_VC = 2560, C_KS = 3072, C_VS = 3584, C_KW = 4096, C_VW = 4608, C_GL = 5120;
constexpr int NTHREADS = 512;
constexpr int LDS_BYTES = 133136;
constexpr int BARST_OFF = 133120;

DI int TID() { int t = threadIdx.x; asm volatile("" : "+v"(t)); return t; }
DI int BID() { int b = blockIdx.x; asm volatile("" : "+s"(b)); return b; }
DI unsigned cvt_pk_bf16(float lo, float hi) { unsigned r; asm volatile("v_cvt_pk_bf16_f32 %0, %1, %2" : "=v"(r) : "v"(lo), "v"(hi)); return r; }
DI float bf2f(bf16_t b) { return __uint_as_float(((unsigned)b) << 16); }
DI float bflo(unsigned w) { return __uint_as_float(w << 16); }
DI float bfhi(unsigned w) { return __uint_as_float(w & 0xffff0000u); }
DI bf16_t f2bf(float f) { return (bf16_t)(cvt_pk_bf16(f, 0.f) & 0xffffu); }
DI float gelu_tanh(float x) { const float u = 0.7978845608028654f * (x + 0.044715f * x * x * x); return x / (1.f + __expf(-2.f * u)); }
DI float sigmoidf_(float x) { return 1.f / (1.f + __expf(-x)); }
DI float xsum_fq(float x) {
    auto a = __builtin_amdgcn_permlane16_swap(__float_as_uint(x), __float_as_uint(x), false, false); x = __uint_as_float(a[0]) + __uint_as_float(a[1]);
    auto b = __builtin_amdgcn_permlane32_swap(__float_as_uint(x), __float_as_uint(x), false, false); return __uint_as_float(b[0]) + __uint_as_float(b[1]);
}
DI float row_rstd(const float* __restrict__ part, int row, int fq) {
    const f32x4 a = *(const f32x4*)(part + (size_t)row * 32 + fq * 8), b = *(const f32x4*)(part + (size_t)row * 32 + fq * 8 + 4);
    const float s = xsum_fq((a[0] + a[1]) + (a[2] + a[3]) + (b[0] + b[1]) + (b[2] + b[3]));
    return rsqrtf(s * (1.f / DM) + 1e-6f);
}

namespace pg8 {
constexpr int BM = 256, BK = 64, HALF = 128, HTB = HALF * BK * 2, STAGE_BYTES = 8 * HTB, NXCD = 8, WGM = 8;
DI int lds_byte(int r, int c) { const int st = (r >> 4) * 2 + (c >> 5), rr = r & 15, cc = c & 31, ob = rr * 64 + cc * 2; return st * 1024 + (ob ^ (((ob >> 9) & 1) << 5)); }
DI void stage_rc(int b, int& R, int& C) { const int st = b / 1024, sb = b % 1024, swz = sb ^ (((sb >> 9) & 1) << 5); R = (st >> 1) * 16 + swz / 64; C = (st & 1) * 32 + (swz % 64) / 2; }
DI int perm32(int rho) { const int n = rho >> 4, i = rho & 15; return 8 * (i >> 2) + 4 * n + (i & 3); }
struct Unit { int pm, pn; };
struct StaticOrder {
    int nM, nN, nwg, G, c;
    DI void init(int M, int N, int G_, int c_) { nM = M / BM; nN = N / BM; nwg = nM * nN; G = G_; c = c_; }
    DI bool next(int i, Unit& u) const {
        const long L = (long)i * G + c; if (L >= nwg) return false;
        int wgid = (int)L; { const int q = nwg / NXCD, r = nwg % NXCD, xcd = wgid % NXCD, off = wgid / NXCD; wgid = (xcd < r ? xcd * (q + 1) : r * (q + 1) + (xcd - r) * q) + off; }
        const int nig = WGM * nN, gid = wgid / nig, fm = gid * WGM, gsz = (nM - fm) < WGM ? (nM - fm) : WGM;
        u.pm = fm + ((wgid % nig) % gsz); u.pn = (wgid % nig) / gsz; return true;
    }
};
template <int MODE> struct Gemm {
    const char* A; const char* Bt; int M, N, nt; unsigned lda, ldb, kstep2;
    DI const char* aptr(int pm) const {
        if (MODE == 0) return A + (size_t)pm * 256 * lda;
        const int kv = pm >> 5, bg = (pm >> 2) & 7, panel = pm & 3, b = bg >> 2, g = bg & 3;
        return A + ((size_t)(b * TT + panel * 4096) * NQKV + C_KC + kv * 512 + g * 128) * 2;
    }
    DI const char* bptr(int pm, int pn) const {
        if (MODE == 0) return Bt + (size_t)pn * 256 * ldb;
        return Bt + (size_t)(pm >> 5) * (512 * 4096 * 2) + (size_t)pn * 256 * ldb;
    }
};

template <class Epi, int MODE>
DI void gemm_phase(LAS unsigned char* lds, const Gemm<MODE> g, const StaticOrder& S, const Epi& E) {
    const int tid = TID(), wid = __builtin_amdgcn_readfirstlane(tid >> 6), lane = tid & 63, wr = wid >> 2, wc = wid & 3, fr = lane & 15, fq = lane >> 4;
    const int nt = g.nt;
    unsigned voffA[2], voffB[2];
#pragma unroll
    for (int i = 0; i < 2; ++i) { int R, C; stage_rc(tid * 16 + i * 8192, R, C); const int Rb = Epi::PERM ? ((R & ~31) + perm32(R & 31)) : R;
        voffA[i] = (unsigned)R * g.lda + (unsigned)C * 2u; voffB[i] = (unsigned)Rb * g.ldb + (unsigned)C * 2u; }
    const size_t kstep = 128;
    const size_t hstepA = (size_t)HALF * g.lda, hstepB = (size_t)HALF * g.ldb;
    const size_t kstep2 = g.kstep2;
    const unsigned ldsw = (unsigned)wid * 1024u;
    const int aoff = lds_byte(wr * 64 + fr, fq * 8), boff = lds_byte(wc * 32 + fr, fq * 8);
#define PG8_SA(b, h) (((b) * 2 + (h)) * HTB)
#define PG8_SB(b, h) ((4 + (b) * 2 + (h)) * HTB)
#define PG8_STAGE(bufoff, gbase, voff) do { _Pragma("unroll") for (int _i = 0; _i < 2; ++_i) \
        __builtin_amdgcn_global_load_lds((const unsigned*)((const char*)(gbase) + (voff)[_i]), (LAS unsigned*)(lds + (bufoff) + ldsw + _i * 8192), 16, 0, 0); } while (0)
#define PG8_LDA(dst, b, h) do { _Pragma("unroll") for (int m = 0; m < 4; ++m) _Pragma("unroll") for (int k = 0; k < 2; ++k) dst[m][k] = *(const LAS bf16x8*)(lds + PG8_SA(b, h) + aoff + m * 2048 + k * 1024); } while (0)
#define PG8_LDB(dst, b, h) do { _Pragma("unroll") for (int n = 0; n < 2; ++n) _Pragma("unroll") for (int k = 0; k < 2; ++k) dst[n][k] = *(const LAS bf16x8*)(lds + PG8_SB(b, h) + boff + n * 2048 + k * 1024); } while (0)
#define PG8_MMA(ai, bj, At, Bt) do { __builtin_amdgcn_s_setprio(1); _Pragma("unroll") for (int m = 0; m < 4; ++m) _Pragma("unroll") for (int n = 0; n < 2; ++n) _Pragma("unroll") for (int k = 0; k < 2; ++k) \
        acc[ai][bj][m][n] = __builtin_amdgcn_mfma_f32_16x16x32_bf16(Bt[n][k], At[m][k], acc[ai][bj][m][n], 0, 0, 0); __builtin_amdgcn_s_setprio(0); } while (0)
#define PG8_WAIT_V(n) asm volatile("s_waitcnt vmcnt(" #n ")" ::: "memory")
#define PG8_WAIT_L(n) asm volatile("s_waitcnt lgkmcnt(" #n ")" ::: "memory")
#define PG8_BAR __builtin_amdgcn_s_barrier()
#define PG8_SCHED __builtin_amdgcn_sched_barrier(0)
    Unit cur, nxt; int ui = 0;
    if (!S.next(0, cur)) return;
    f32x4 acc[2][2][4][2];
#pragma unroll
    for (int a = 0; a < 2; ++a)
#pragma unroll
        for (int b = 0; b < 2; ++b)
#pragma unroll
            for (int m = 0; m < 4; ++m)
#pragma unroll
                for (int n = 0; n < 2; ++n) acc[a][b][m][n] = (f32x4){0.f, 0.f, 0.f, 0.f};
    bf16x8 At[4][2], B0[2][2], B1[2][2];
    const char* cA = g.aptr(cur.pm); const char* cB = g.bptr(cur.pm, cur.pn);
    PG8_STAGE(PG8_SB(0, 0), cB, voffB); PG8_STAGE(PG8_SA(0, 0), cA, voffA); PG8_STAGE(PG8_SB(0, 1), cB + hstepB, voffB); PG8_STAGE(PG8_SA(0, 1), cA + hstepA, voffA);
    if (wr == 1) PG8_BAR;
    PG8_WAIT_V(4); PG8_BAR;
    PG8_STAGE(PG8_SB(1, 0), cB + kstep, voffB); PG8_STAGE(PG8_SA(1, 0), cA + kstep, voffA); PG8_STAGE(PG8_SB(1, 1), cB + hstepB + kstep, voffB);
    PG8_WAIT_V(6); PG8_BAR;
    for (;;) {
        const bool has_next = S.next(ui + 1, nxt);
        const char* nA = has_next ? g.aptr(nxt.pm) : cA; const char* nB = has_next ? g.bptr(nxt.pm, nxt.pn) : cB;
        for (int t = 0; t < nt; t += 2) {
            const bool last = (t == nt - 2);
            const char* a1 = cA + (size_t)(t >> 1) * kstep2 + kstep;
            const char* a2 = last ? nA : cA + (size_t)((t + 2) >> 1) * kstep2; const char* b2 = last ? nB : cB + (size_t)(t + 2) * kstep;
            const char* a3 = a2 + kstep; const char* b3 = b2 + kstep;
            PG8_LDB(B0, 0, 0); PG8_SCHED; PG8_LDA(At, 0, 0); PG8_STAGE(PG8_SA(1, 1), a1 + hstepA, voffA);
            PG8_WAIT_L(8); PG8_BAR; PG8_WAIT_L(0); PG8_MMA(0, 0, At, B0); PG8_BAR; PG8_SCHED;
            PG8_LDB(B1, 0, 1); PG8_STAGE(PG8_SB(0, 0), b2, voffB);
            PG8_BAR; PG8_WAIT_L(0); PG8_MMA(0, 1, At, B1); PG8_BAR;
            PG8_LDA(At, 0, 1); PG8_STAGE(PG8_SA(0, 0), a2, voffA);
            PG8_BAR; PG8_WAIT_L(0); PG8_MMA(1, 0, At, B0); PG8_BAR; PG8_SCHED;
            PG8_STAGE(PG8_SB(0, 1), b2 + hstepB, voffB);
            PG8_WAIT_V(6); PG8_BAR; PG8_MMA(1, 1, At, B1); PG8_BAR;
            PG8_LDB(B0, 1, 0); PG8_SCHED; PG8_LDA(At, 1, 0); PG8_STAGE(PG8_SA(0, 1), a2 + hstepA, voffA);
            PG8_WAIT_L(8); PG8_BAR; PG8_WAIT_L(0); PG8_MMA(0, 0, At, B0); PG8_BAR; PG8_SCHED;
            PG8_LDB(B1, 1, 1); PG8_STAGE(PG8_SB(1, 0), b3, voffB);
            PG8_BAR; PG8_WAIT_L(0); PG8_MMA(0, 1, At, B1); PG8_BAR;
            PG8_LDA(At, 1, 1); PG8_STAGE(PG8_SA(1, 0), a3, voffA);
            PG8_BAR; PG8_WAIT_L(0); PG8_MMA(1, 0, At, B0); PG8_BAR; PG8_SCHED;
            PG8_STAGE(PG8_SB(1, 1), b3 + hstepB, voffB);
            PG8_WAIT_V(6); PG8_BAR; PG8_MMA(1, 1, At, B1); PG8_BAR;
        }
        E(acc, cur, wr, wc, fr, fq);
        if (!has_next) break;
#pragma unroll
        for (int a = 0; a < 2; ++a)
#pragma unroll
            for (int b = 0; b < 2; ++b)
#pragma unroll
                for (int m = 0; m < 4; ++m)
#pragma unroll
                    for (int n = 0; n < 2; ++n) acc[a][b][m][n] = (f32x4){0.f, 0.f, 0.f, 0.f};
        cur = nxt; cA = nA; cB = nB; ++ui;
    }
    PG8_WAIT_V(0);
    if (wr == 0) PG8_BAR;
    PG8_BAR;
#undef PG8_SA
#undef PG8_SB
#undef PG8_STAGE
#undef PG8_LDA
#undef PG8_LDB
#undef PG8_MMA
#undef PG8_WAIT_V
#undef PG8_WAIT_L
#undef PG8_BAR
#undef PG8_SCHED
}

template <int ACT, bool BIASPM> struct EpiAct {
    static constexpr bool PERM = true;
    bf16_t* O; int ldc; const float* bias; const float* part;
    DI void operator()(const f32x4 (&acc)[2][2][4][2], const Unit& u, int wr, int wc, int fr, int fq) const {
        const int row0 = u.pm * BM + wr * 64 + fr; const int col0 = u.pn * BM + wc * 32 + 8 * fq;
        f32x4 bv[2][2];
#pragma unroll
        for (int bj = 0; bj < 2; ++bj)
#pragma unroll
            for (int n = 0; n < 2; ++n) bv[bj][n] = BIASPM ? *(const f32x4*)(bias + (u.pm >> 5) * 512 + col0 + bj * HALF + 4 * n) : (f32x4){0.f, 0.f, 0.f, 0.f};
#pragma unroll
        for (int ai = 0; ai < 2; ++ai)
#pragma unroll
            for (int m = 0; m < 4; ++m) { const int row = row0 + ai * HALF + m * 16; bf16_t* rowp = O + (size_t)row * ldc + col0;
                const float rs = part ? row_rstd(part, row, fq) : 1.f;
#pragma unroll
                for (int bj = 0; bj < 2; ++bj) { f32x4 v0 = acc[ai][bj][m][0] * rs + bv[bj][0], v1 = acc[ai][bj][m][1] * rs + bv[bj][1];
                    if (ACT == 1) {
#pragma unroll
                        for (int j = 0; j < 4; ++j) { v0[j] = gelu_tanh(v0[j]); v1[j] = gelu_tanh(v1[j]); } }
                    if (ACT == 2) {
#pragma unroll
                        for (int j = 0; j < 4; ++j) { const float a = fmaxf(v0[j], 0.f), b = fmaxf(v1[j], 0.f); v0[j] = a * a; v1[j] = b * b; } }
                    u32x4 w; w.x = cvt_pk_bf16(v0[0], v0[1]); w.y = cvt_pk_bf16(v0[2], v0[3]); w.z = cvt_pk_bf16(v1[0], v1[1]); w.w = cvt_pk_bf16(v1[2], v1[3]);
                    *(u32x4*)(rowp + bj * HALF) = w; } }
    }
};
template <bool GATE> struct EpiResN {
    static constexpr bool PERM = false;
    const float* base; float* out; const bf16_t* pp; const float* part_in; const float* gnext; bf16_t* Hn; float* part_out;
    DI void operator()(const f32x4 (&acc)[2][2][4][2], const Unit& u, int wr, int wc, int fr, int fq) const {
        const int row0 = u.pm * BM + wr * 64 + fr, col0 = u.pn * BM + wc * 32 + 4 * fq;
        f32x4 gv[2][2];
#pragma unroll
        for (int bj = 0; bj < 2; ++bj)
#pragma unroll
            for (int n = 0; n < 2; ++n) gv[bj][n] = Hn ? *(const f32x4*)(gnext + col0 + bj * HALF + n * 16) : (f32x4){0.f, 0.f, 0.f, 0.f};
        constexpr int MB = GATE ? 1 : 2;
#pragma unroll
        for (int ai = 0; ai < 2; ++ai)
#pragma unroll
            for (int m0 = 0; m0 < 4; m0 += MB) {
                f32x4 bs[MB][4]; u32x2 pw[MB][4]; float rs[MB];
#pragma unroll
                for (int mm = 0; mm < MB; ++mm) { const int row = row0 + ai * HALF + (m0 + mm) * 16; const size_t off = (size_t)row * DM + col0;
#pragma unroll
                    for (int q = 0; q < 4; ++q) { const size_t o = off + (q >> 1) * HALF + (q & 1) * 16; bs[mm][q] = *(const f32x4*)(base + o); if (GATE) pw[mm][q] = *(const u32x2*)(pp + o); }
                    rs[mm] = GATE ? row_rstd(part_in, row, fq) : 1.f; }
#pragma unroll
                for (int mm = 0; mm < MB; ++mm) { const int m = m0 + mm, row = row0 + ai * HALF + m * 16; const size_t off = (size_t)row * DM + col0; float ss = 0.f;
#pragma unroll
                    for (int q = 0; q < 4; ++q) { const int bj = q >> 1, n = q & 1; const size_t o = off + bj * HALF + n * 16; const f32x4 b = bs[mm][q]; const f32x4 a = acc[ai][bj][m][n]; f32x4 r;
                        if (GATE) { const u32x2 w2 = pw[mm][q]; const float s = rs[mm];
                            r[0] = b[0] + sigmoidf_(a[0] * s) * bflo(w2.x); r[1] = b[1] + sigmoidf_(a[1] * s) * bfhi(w2.x); r[2] = b[2] + sigmoidf_(a[2] * s) * bflo(w2.y); r[3] = b[3] + sigmoidf_(a[3] * s) * bfhi(w2.y); }
                        else r = b + a;
                        *(f32x4*)(out + o) = r;
                        if (Hn) { ss += (r[0] * r[0] + r[1] * r[1]) + (r[2] * r[2] + r[3] * r[3]); const f32x4 g = gv[bj][n];
                            u32x2 w; w.x = cvt_pk_bf16(r[0] * g[0], r[1] * g[1]); w.y = cvt_pk_bf16(r[2] * g[2], r[3] * g[3]); *(u32x2*)(Hn + o) = w; } }
                    if (Hn) { ss = xsum_fq(ss); if (fq == 0) part_out[(size_t)row * 32 + u.pn * 4 + wc] = ss; } }
            }
    }
};
}
#define XB_TMO      128
#define XB_XCNT(j)  (256  + 64 * (j))
#define XB_XSUB(j)  (1280 + 64 * (j))
#define XB_XGEN(j)  (2304 + 64 * (j))
#define XB_TOP      3328
#define XB_TOPGEN   3392
#define XCD_BAR_WORDS 3456
#define XB_SPIN_CAP (1u << 18)

__device__ __forceinline__ unsigned xb_ld(unsigned* p)              { return __hip_atomic_load(p, __ATOMIC_RELAXED, __HIP_MEMORY_SCOPE_AGENT); }
__device__ __forceinline__ unsigned xb_add(unsigned* p, unsigned v) { return __hip_atomic_fetch_add(p, v, __ATOMIC_RELAXED, __HIP_MEMORY_SCOPE_AGENT); }
__device__ __forceinline__ unsigned xb_xcc_id() { return (unsigned)__builtin_amdgcn_s_getreg((3 << 11) | 20) & 0xFu; }
#define XB_SPIN(cond, bar) do { unsigned _sp = 0; while (cond) { __builtin_amdgcn_s_sleep(1); \
    if ((++_sp & 255u) == 0u) { if (xb_ld(&(bar)[XB_TMO])) break; if (_sp > XB_SPIN_CAP) { atomicAdd(&(bar)[XB_TMO], 1u); break; } } } } while (0)

struct XcdBarrier {
    unsigned* bar; unsigned x;
    volatile LAS unsigned* st;
};

__device__ __forceinline__ XcdBarrier xcd_barrier_post(unsigned* bar, volatile LAS unsigned* st) {
    XcdBarrier b; b.bar = bar; b.x = xb_xcc_id(); b.st = st;
    if (threadIdx.x == 0) (void)xb_add(&bar[XB_XCNT(b.x)], 1u);
    return b;
}
__device__ __forceinline__ void xcd_barrier_complete(unsigned* bar, unsigned x, unsigned& nloc, unsigned& nx) {
    const unsigned G = gridDim.x * gridDim.y * gridDim.z;
    unsigned sum, cnt, mine, sp = 0u;
    for (;;) {
        sum = 0u; cnt = 0u; mine = 0u;
#pragma unroll
        for (unsigned j = 0; j < 16; ++j) { const unsigned c = xb_ld(&bar[XB_XCNT(j)]); sum += c; cnt += (c > 0u) ? 1u : 0u; mine = (j == x) ? c : mine; }
        if (sum == G) break;
        __builtin_amdgcn_s_sleep(1);
        if ((++sp & 255u) == 0u) { if (xb_ld(&bar[XB_TMO])) break; if (sp > XB_SPIN_CAP) { atomicAdd(&bar[XB_TMO], 1u); break; } }
    }
    nloc = mine > 0u ? mine : 1u; nx = cnt > 0u ? cnt : 1u;
}

__device__ __forceinline__ void xcd_barrier(const XcdBarrier& b) {
    asm volatile("s_waitcnt vmcnt(0)" ::: "memory");
    __syncthreads();
    if (threadIdx.x == 0) {
        unsigned* bar = b.bar;
        __builtin_amdgcn_s_waitcnt(0);
        unsigned nloc = b.st[0], nx = b.st[1];
        if (nloc == 0u) { xcd_barrier_complete(bar, b.x, nloc, nx); b.st[0] = nloc; b.st[1] = nx; }
        const unsigned old = xb_add(&bar[XB_XSUB(b.x)], 1u);
        const unsigned gen = old / nloc;
        if (old + 1u == (gen + 1u) * nloc) {
            __builtin_amdgcn_fence(__ATOMIC_RELEASE, "agent");
            asm volatile("s_waitcnt vmcnt(0)" ::: "memory");
            const unsigned og = xb_add(&bar[XB_TOP], 1u);
            const unsigned tg = og / nx;
            if (og + 1u == (tg + 1u) * nx) xb_add(&bar[XB_TOPGEN], 1u);
            else XB_SPIN(xb_ld(&bar[XB_TOPGEN]) == tg, bar);
            __builtin_amdgcn_fence(__ATOMIC_ACQUIRE, "agent");
            xb_add(&bar[XB_XGEN(b.x)], 1u);
            asm volatile("s_waitcnt vmcnt(0)" ::: "memory");
        } else {
            XB_SPIN(xb_ld(&bar[XB_XGEN(b.x)]) == gen, bar);
            __builtin_amdgcn_fence(__ATOMIC_ACQUIRE, "agent");
            asm volatile("s_waitcnt vmcnt(0)" ::: "memory");
        }
    }
    __syncthreads();
}


__constant__ float ROPE_INV[16] = {1.0f, 0.44036659598350525f, 0.1939227432012558f, 0.08539710193872452f, 0.03760603070259094f, 0.01656043902039528f, 0.007292664609849453f, 0.0032114458736032248f,
    0.0014142135623842478f, 0.000622772378847003f, 0.00027424818836152554f, 0.00012076973507646471f, 5.318296098266728e-05f, 2.34199997066753e-05f, 1.0313386155758053e-05f, 4.541670477919979e-06f};

DI float wave_sum(float v) {
#pragma unroll
    for (int o = 32; o >= 1; o >>= 1) v += __shfl_xor(v, o);
    return v;
}
DI void rope_sincos(int pos, int i, float& sn, float& cs) {
    const float ang = (float)pos * ROPE_INV[i];
    const double a = (double)ang; const double k = __builtin_rint(a * 0.15915494309189535); const float r = (float)(a - k * 6.283185307179586);
    sn = __sinf(r); cs = __cosf(r);
}

DI void transpose_w(const float* __restrict__ W, bf16_t* __restrict__ Wt, int R, int C, int Cpad, LAS float* tile) {
    const int tid = TID(), bid = BID(), ntr = R / 64, ntc = Cpad / 64, ntiles = ntr * ntc;
    for (int t0 = bid * 4; t0 < ntiles; t0 += gridDim.x * 4) {
        float v[4][8];
#pragma unroll
        for (int u = 0; u < 4; ++u) { const int t = t0 + u; const int r0 = (t % ntr) * 64, c0 = (t / ntr) * 64;
#pragma unroll
            for (int i = 0; i < 8; ++i) { const int idx = tid + 512 * i, r = idx >> 6, c = idx & 63;
                v[u][i] = (t < ntiles && c0 + c < C) ? W[(size_t)(r0 + r) * C + c0 + c] : 0.f; } }
#pragma unroll
        for (int u = 0; u < 4; ++u)
#pragma unroll
            for (int i = 0; i < 8; ++i) { const int idx = tid + 512 * i, r = idx >> 6, c = idx & 63; tile[u * 4160 + c * 65 + r] = v[u][i]; }
        __syncthreads();
#pragma unroll
        for (int u = 0; u < 4; ++u) { const int t = t0 + u; if (t < ntiles) { const int r0 = (t % ntr) * 64, c0 = (t / ntr) * 64;
            const int c = tid >> 3, r8 = (tid & 7) * 8; const LAS float* p = tile + u * 4160 + c * 65 + r8;
            u32x4 w; w.x = cvt_pk_bf16(p[0], p[1]); w.y = cvt_pk_bf16(p[2], p[3]); w.z = cvt_pk_bf16(p[4], p[5]); w.w = cvt_pk_bf16(p[6], p[7]);
            *(u32x4*)(Wt + (size_t)(c0 + c) * R + r0 + r8) = w; } }
        __syncthreads();
    }
}
DI void convert_f32_bf16(const float* __restrict__ src, bf16_t* __restrict__ dst, size_t n) {
    const size_t nth = (size_t)gridDim.x * NTHREADS;
    const int tid = TID(), bid = BID();
    for (size_t i = ((size_t)bid * NTHREADS + tid) * 8; i < n; i += nth * 8) {
        const f32x4 a = *(const f32x4*)(src + i), b = *(const f32x4*)(src + i + 4);
        u32x4 w; w.x = cvt_pk_bf16(a[0], a[1]); w.y = cvt_pk_bf16(a[2], a[3]); w.z = cvt_pk_bf16(b[0], b[1]); w.w = cvt_pk_bf16(b[2], b[3]);
        *(u32x4*)(dst + i) = w; }
}
DI void pe_bias_partial(const float* __restrict__ kpe, const float* __restrict__ kw1, const float* __restrict__ vpe, const float* __restrict__ vw1, float* __restrict__ part, LAS float* red) {
    const int tid = TID(), bid = BID();
    for (int it = bid; it < 256; it += gridDim.x) {
        const int kv = it >> 7, cg8 = (it >> 4) & 7, ks = it & 15; const float* pe = kv ? vpe : kpe; const float* w1 = kv ? vw1 : kw1;
        const int n = cg8 * 64 + (tid & 63), sub = tid >> 6; float s = 0.f;
#pragma unroll 8
        for (int j = 0; j < 32; ++j) { const int k = ks * 256 + sub * 32 + j; s += pe[k] * w1[(size_t)k * 512 + n]; }
        red[tid] = s; __syncthreads();
        if (tid < 64) { float a = 0.f;
#pragma unroll
            for (int q = 0; q < 8; ++q) a += red[q * 64 + tid]; part[(kv * 16 + ks) * 512 + n] = a; }
        __syncthreads();
    }
}
DI void rmsnorm_bf16(const float* __restrict__ x, const float* __restrict__ g, bf16_t* __restrict__ out) {
    const int tid = TID(), bid = BID(); const int lane = tid & 63, gw = bid * 8 + (tid >> 6), nw = gridDim.x * 8;
    for (int row = gw; row < MT; row += nw) {
        const float* xr = x + (size_t)row * DM; f32x4 v[8]; float ss = 0.f;
#pragma unroll
        for (int k = 0; k < 8; ++k) { v[k] = *(const f32x4*)(xr + k * 256 + lane * 4); ss += v[k][0] * v[k][0] + v[k][1] * v[k][1] + v[k][2] * v[k][2] + v[k][3] * v[k][3]; }
        ss = wave_sum(ss); const float r = rsqrtf(ss * (1.f / DM) + 1e-6f);
#pragma unroll
        for (int k = 0; k < 8; ++k) { const f32x4 gk = *(const f32x4*)(g + k * 256 + lane * 4); u32x2 w; w.x = cvt_pk_bf16(v[k][0] * r * gk[0], v[k][1] * r * gk[1]); w.y = cvt_pk_bf16(v[k][2] * r * gk[2], v[k][3] * r * gk[3]);
            *(u32x2*)(out + (size_t)row * DM + k * 256 + lane * 4) = w; }
    }
}
DI void rmsnorm_f32_inplace(float* __restrict__ x, const float* __restrict__ g) {
    const int tid = TID(), bid = BID(); const int lane = tid & 63, gw = bid * 8 + (tid >> 6), nw = gridDim.x * 8;
    for (int row = gw; row < MT; row += nw) {
        float* xr = x + (size_t)row * DM; f32x4 v[8]; float ss = 0.f;
#pragma unroll
        for (int k = 0; k < 8; ++k) { v[k] = *(const f32x4*)(xr + k * 256 + lane * 4); ss += v[k][0] * v[k][0] + v[k][1] * v[k][1] + v[k][2] * v[k][2] + v[k][3] * v[k][3]; }
        ss = wave_sum(ss); const float r = rsqrtf(ss * (1.f / DM) + 1e-6f);
#pragma unroll
        for (int k = 0; k < 8; ++k) { const f32x4 gk = *(const f32x4*)(g + k * 256 + lane * 4); *(f32x4*)(xr + k * 256 + lane * 4) = v[k] * r * gk; }
    }
}

DI void gmlp_gate(const bf16_t* __restrict__ Z, const float* __restrict__ lng, const float* __restrict__ lnb, const float* __restrict__ gws, const float* __restrict__ gbs,
                  bf16_t* __restrict__ Hout, LAS unsigned char* lds) {
    LAS float* stat = (LAS float*)lds;
    LAS unsigned char* vt = lds + 1024;
    const int tid = TID(), bid = BID(), w = tid >> 6, lane = tid & 63, fr = lane & 15, fq = lane >> 4;
    for (int chunk = bid; chunk < MT / 128; chunk += gridDim.x) {
        const int tok0 = chunk * 128;
#pragma unroll 1
        for (int i0 = 0; i0 < 16; i0 += 4) { u32x4 q[4][4];
#pragma unroll
            for (int i = 0; i < 4; ++i)
#pragma unroll
                for (int k = 0; k < 4; ++k) q[i][k] = *(const u32x4*)(Z + (size_t)(tok0 + 16 * w + i0 + i) * 4096 + 2048 + (k * 64 + lane) * 8);
#pragma unroll
            for (int i = 0; i < 4; ++i) { const int s = 16 * w + i0 + i; float sm = 0.f, sq = 0.f;
#pragma unroll
                for (int k = 0; k < 4; ++k)
#pragma unroll
                    for (int e = 0; e < 4; ++e) { const float a = bflo(q[i][k][e]), b = bfhi(q[i][k][e]); sm += a + b; sq += a * a + b * b; }
                sm = wave_sum(sm); sq = wave_sum(sq); const float mean = sm * (1.f / 2048.f), var = sq * (1.f / 2048.f) - mean * mean;
                if (lane == 0) { stat[2 * s] = mean; stat[2 * s + 1] = rsqrtf(fmaxf(var, 0.f) + 1e-6f); } } }
        __syncthreads();
        const int t = 16 * w + fr, nks = (16 * w + 15) / 32 + 1, tok = tok0 + t;
        u32x4 vq[4]; u32x2 uq[8];
#define GM_LOADV(g_) do { _Pragma("unroll") for (int i_ = 0; i_ < 4; ++i_) { const int cid_ = tid + 512 * i_; vq[i_] = *(const u32x4*)(Z + (size_t)(tok0 + (cid_ >> 4)) * 4096 + 2048 + (g_) * 128 + (cid_ & 15) * 8); } } while (0)
#define GM_LOADU(g_) do { _Pragma("unroll") for (int dt_ = 0; dt_ < 8; ++dt_) uq[dt_] = *(const u32x2*)(Z + (size_t)tok * 4096 + (g_) * 128 + 16 * dt_ + 4 * fq); } while (0)
        GM_LOADV(0);
        for (int g = 0; g < 16; ++g) {
#pragma unroll
            for (int i = 0; i < 4; ++i) { const int cid = tid + 512 * i, s = cid >> 4, c8 = (cid & 15) * 8;
                const u32x4 q = vq[i]; const float mean = stat[2 * s], rstd = stat[2 * s + 1];
                const f32x4 g0 = *(const f32x4*)(lng + g * 128 + c8), g1 = *(const f32x4*)(lng + g * 128 + c8 + 4), b0 = *(const f32x4*)(lnb + g * 128 + c8), b1 = *(const f32x4*)(lnb + g * 128 + c8 + 4);
                float y[8];
#pragma unroll
                for (int e = 0; e < 4; ++e) { y[2 * e] = bflo(q[e]); y[2 * e + 1] = bfhi(q[e]); }
#pragma unroll
                for (int e = 0; e < 8; ++e) { const float gg = e < 4 ? g0[e & 3] : g1[e & 3], bb = e < 4 ? b0[e & 3] : b1[e & 3]; const float yn = (y[e] - mean) * rstd * gg + bb;
                    const int d = c8 + e; *(LAS bf16_t*)(vt + d * 256 + ((((s >> 3) ^ ((d >> 3) & 15)) << 4) | ((s & 7) << 1))) = f2bf(yn); } }
            GM_LOADU(g);
            if (g + 1 < 16) GM_LOADV(g + 1);
            __syncthreads();
            f32x4 acc[8];
#pragma unroll
            for (int dt = 0; dt < 8; ++dt) acc[dt] = (f32x4){0.f, 0.f, 0.f, 0.f};
            for (int ks = 0; ks < nks; ++ks) {
                const float* wp = gws + ((size_t)(g * 128 + t)) * 128 + ks * 32 + fq * 8; const f32x4 w0 = *(const f32x4*)wp, w1 = *(const f32x4*)(wp + 4); const int s0 = ks * 32 + fq * 8;
                float wv[8];
#pragma unroll
                for (int e = 0; e < 8; ++e) { const float x = e < 4 ? w0[e & 3] : w1[e & 3]; wv[e] = (s0 + e <= t) ? x : 0.f; }
                u32x4 wq; wq.x = cvt_pk_bf16(wv[0], wv[1]); wq.y = cvt_pk_bf16(wv[2], wv[3]); wq.z = cvt_pk_bf16(wv[4], wv[5]); wq.w = cvt_pk_bf16(wv[6], wv[7]);
                const bf16x8 wf = __builtin_bit_cast(bf16x8, wq);
#pragma unroll
                for (int dt = 0; dt < 8; ++dt) { const int d = 16 * dt + fr; const bf16x8 a = *(const LAS bf16x8*)(vt + d * 256 + (((ks * 4 + fq) ^ ((d >> 3) & 15)) << 4));
                    acc[dt] = __builtin_amdgcn_mfma_f32_16x16x32_bf16(a, wf, acc[dt], 0, 0, 0); }
            }
            { const float bias = gbs[g * 128 + t];
#pragma unroll
              for (int dt = 0; dt < 8; ++dt) { const int col = g * 128 + 16 * dt + 4 * fq; const u32x2 u2 = uq[dt];
                  u32x2 o; o.x = cvt_pk_bf16((acc[dt][0] + bias) * bflo(u2.x), (acc[dt][1] + bias) * bfhi(u2.x)); o.y = cvt_pk_bf16((acc[dt][2] + bias) * bflo(u2.y), (acc[dt][3] + bias) * bfhi(u2.y));
                  *(u32x2*)(Hout + (size_t)tok * DM + col) = o; } }
            __syncthreads();
        }
#undef GM_LOADV
#undef GM_LOADU
    }
}

DI void rope_qkv(bf16_t* __restrict__ QKV, int wg0, int nwg) {
    const int tid = TID(); const int b = BID() - wg0; if (b < 0 || b >= nwg) return;
    for (int idx = b * NTHREADS + tid; idx < MT * 16; idx += nwg * NTHREADS) {
        const int tok = idx >> 4, i = idx & 15; float sn, cs; rope_sincos(tok & (TT - 1), i, sn, cs);
        bf16_t* row = QKV + (size_t)tok * NQKV;
        bf16_t a1[24], a2[24];
#pragma unroll
        for (int h = 0; h < 24; ++h) { const int col = (h < 16 ? h * 128 : (h < 20 ? C_KS + (h - 16) * 128 : C_KW + (h - 20) * 128)) + i; a1[h] = row[col]; a2[h] = row[col + 16]; }
#pragma unroll
        for (int h = 0; h < 24; ++h) { const int col = (h < 16 ? h * 128 : (h < 20 ? C_KS + (h - 16) * 128 : C_KW + (h - 20) * 128)) + i;
            const float x1 = bf2f(a1[h]), x2 = bf2f(a2[h]); row[col] = f2bf(x1 * cs - x2 * sn); row[col + 16] = f2bf(x2 * cs + x1 * sn); }
    }
}
DI void transpose_v(const bf16_t* __restrict__ QKV, bf16_t* __restrict__ VSt, bf16_t* __restrict__ VWt, int wg0, int nwg, LAS unsigned char* lds) {
    const int blk = BID() - wg0; if (blk < 0 || blk >= nwg) return;
    const int tid = TID();
    for (int it = blk; it < 4096; it += nwg) {
        const int sel = it >> 11, bg = (it >> 8) & 7, tb = it & 255, b = bg >> 2, g = bg & 3;
        const bf16_t* src = QKV + (size_t)(b * TT + tb * 64) * NQKV + (sel ? C_VW : C_VS) + g * 128; bf16_t* dst = (sel ? VWt : VSt) + (size_t)bg * 128 * TT + tb * 64;
#pragma unroll
        for (int i = 0; i < 2; ++i) { const int cid = tid + 512 * i, t = cid >> 4, c8 = (cid & 15) * 8; *(LAS u32x4*)(lds + t * 272 + c8 * 2) = *(const u32x4*)(src + (size_t)t * NQKV + c8); }
        __syncthreads();
#pragma unroll
        for (int i = 0; i < 2; ++i) { const int cid = tid + 512 * i, d = cid >> 3, t8 = (cid & 7) * 8; unsigned short e[8];
#pragma unroll
            for (int k = 0; k < 8; ++k) e[k] = *(const LAS bf16_t*)(lds + (t8 + k) * 272 + d * 2);
            u32x4 w; w.x = e[0] | ((unsigned)e[1] << 16); w.y = e[2] | ((unsigned)e[3] << 16); w.z = e[4] | ((unsigned)e[5] << 16); w.w = e[6] | ((unsigned)e[7] << 16);
            *(u32x4*)(dst + (size_t)d * TT + t8) = w; }
        __syncthreads();
    }
}
DI void compress2(const bf16_t* __restrict__ HID, const bf16_t* __restrict__ W2t  , bf16_t* __restrict__ KC, bf16_t* __restrict__ VCt) {
    const int tid = TID(); const int lane = tid & 63, fr = lane & 15, fq = lane >> 4, gw = BID() * 8 + (tid >> 6), nw = gridDim.x * 8;
    for (int unit0 = gw; unit0 < 1024; unit0 += nw) {
        const int unit = __builtin_amdgcn_readfirstlane(unit0);
        const int r0 = unit * 16, kv = r0 >> 13, bg = (r0 >> 10) & 7, c0 = r0 & 1023;
        f32x4 acc[8];
#pragma unroll
        for (int nt = 0; nt < 8; ++nt) acc[nt] = (f32x4){0.f, 0.f, 0.f, 0.f};
        const bf16_t* ap = HID + (size_t)(r0 + fr) * 512 + fq * 8; const bf16_t* bp = W2t + (size_t)kv * 128 * 512 + (size_t)fr * 512 + fq * 8;
        if (kv == 0) {
#pragma unroll 2
            for (int ks = 0; ks < 16; ++ks) { const bf16x8 a = *(const bf16x8*)(ap + ks * 32); bf16x8 bq[8];
#pragma unroll
                for (int nt = 0; nt < 8; ++nt) bq[nt] = *(const bf16x8*)(bp + (size_t)nt * 16 * 512 + ks * 32);
                asm volatile("" : "+v"(bq[0]), "+v"(bq[1]), "+v"(bq[2]), "+v"(bq[3]), "+v"(bq[4]), "+v"(bq[5]), "+v"(bq[6]), "+v"(bq[7]));
#pragma unroll
                for (int nt = 0; nt < 8; ++nt) acc[nt] = __builtin_amdgcn_mfma_f32_16x16x32_bf16(bq[nt], a, acc[nt], 0, 0, 0); }
            const int c = c0 + fr; const bool dead = (c == 1023);
#pragma unroll
            for (int j = 0; j < 4; ++j) { float sn, cs; rope_sincos(16 * c + 31, 4 * fq + j, sn, cs); const float x1 = acc[0][j], x2 = acc[1][j]; acc[0][j] = x1 * cs - x2 * sn; acc[1][j] = x2 * cs + x1 * sn; }
#pragma unroll
            for (int nt = 0; nt < 8; ++nt) { u32x2 o; o.x = cvt_pk_bf16(acc[nt][0], acc[nt][1]); o.y = cvt_pk_bf16(acc[nt][2], acc[nt][3]); if (dead) { o.x = 0u; o.y = 0u; }
                *(u32x2*)(KC + ((size_t)bg * 1024 + c) * 128 + 16 * nt + 4 * fq) = o; }
        } else {
#pragma unroll 2
            for (int ks = 0; ks < 16; ++ks) { const bf16x8 a = *(const bf16x8*)(ap + ks * 32); bf16x8 bq[8];
#pragma unroll
                for (int nt = 0; nt < 8; ++nt) bq[nt] = *(const bf16x8*)(bp + (size_t)nt * 16 * 512 + ks * 32);
                asm volatile("" : "+v"(bq[0]), "+v"(bq[1]), "+v"(bq[2]), "+v"(bq[3]), "+v"(bq[4]), "+v"(bq[5]), "+v"(bq[6]), "+v"(bq[7]));
#pragma unroll
                for (int nt = 0; nt < 8; ++nt) acc[nt] = __builtin_amdgcn_mfma_f32_16x16x32_bf16(a, bq[nt], acc[nt], 0, 0, 0); }
#pragma unroll
            for (int nt = 0; nt < 8; ++nt) { const int c = c0 + 4 * fq; float v3 = acc[nt][3]; if (c + 3 == 1023) v3 = 0.f; u32x2 o; o.x = cvt_pk_bf16(acc[nt][0], acc[nt][1]); o.y = cvt_pk_bf16(acc[nt][2], v3);
                *(u32x2*)(VCt + ((size_t)bg * 128 + 16 * nt + fr) * 1024 + c) = o; }
        }
    }
}
namespace nsa {
constexpr int SLOT = 32768, VT_IN_SLOT = 16384, SEL_OFF = 131072, IMP_OFF = 0;
constexpr int ATT_LDS = 131072 + 2048;
constexpr float C2 = 0.08838834764831845f * 1.4426950408889634f;
constexpr float THR_RAW = 8.0f / C2;
struct SubState { float m[2], l[2], carry[2]; f32x4 o[2][8]; f32x4 la[2]; };

DI float xmax16(float x) { auto r = __builtin_amdgcn_permlane16_swap(__float_as_uint(x), __float_as_uint(x), false, false); return fmaxf(__uint_as_float(r[0]), __uint_as_float(r[1])); }
DI float xmax32(float x) { auto r = __builtin_amdgcn_permlane32_swap(__float_as_uint(x), __float_as_uint(x), false, false); return fmaxf(__uint_as_float(r[0]), __uint_as_float(r[1])); }
DI float xsum16(float x) { auto r = __builtin_amdgcn_permlane16_swap(__float_as_uint(x), __float_as_uint(x), false, false); return __uint_as_float(r[0]) + __uint_as_float(r[1]); }
DI float xsum32(float x) { auto r = __builtin_amdgcn_permlane32_swap(__float_as_uint(x), __float_as_uint(x), false, false); return __uint_as_float(r[0]) + __uint_as_float(r[1]); }
DI float quad_sum(float x) {
    x += __int_as_float(__builtin_amdgcn_update_dpp(0, __float_as_int(x), 0xB1, 0xF, 0xF, false));
    x += __int_as_float(__builtin_amdgcn_update_dpp(0, __float_as_int(x), 0x4E, 0xF, 0xF, false));
    return x;
}

DI unsigned wave_or(unsigned x) {
    x |= (unsigned)__builtin_amdgcn_update_dpp(0, (int)x, 0x128, 0xF, 0xF, false); x |= (unsigned)__builtin_amdgcn_update_dpp(0, (int)x, 0x124, 0xF, 0xF, false);
    x |= (unsigned)__builtin_amdgcn_update_dpp(0, (int)x, 0x122, 0xF, 0xF, false); x |= (unsigned)__builtin_amdgcn_update_dpp(0, (int)x, 0x121, 0xF, 0xF, false);
    { auto r = __builtin_amdgcn_permlane16_swap(x, x, false, false); x = r[0] | r[1]; }
    { auto r = __builtin_amdgcn_permlane32_swap(x, x, false, false); x = r[0] | r[1]; }
    return x;
}
#define NSA_DSR4(d0, d1, d2, d3, addr) asm volatile("ds_read_b128 %0, %4\n\tds_read_b128 %1, %4 offset:4096\n\tds_read_b128 %2, %4 offset:8192\n\tds_read_b128 %3, %4 offset:12288" \
        : "=&v"(d0), "=&v"(d1), "=&v"(d2), "=&v"(d3) : "v"(addr) : "memory")
#define NSA_WAIT4(n, a, b, c, d) asm volatile("s_waitcnt lgkmcnt(" #n ")" : "+v"(a), "+v"(b), "+v"(c), "+v"(d) :: "memory")
DI void qk_tile(f32x4 (&s)[4], const LAS unsigned char* sl, const int (&kra)[4], const bf16x8 (&qf)[4]) {
    const unsigned base = (unsigned)(size_t)sl;
    bf16x8 a0, a1, a2, a3, b0, b1, b2, b3; const f32x4 z = {0.f, 0.f, 0.f, 0.f};
    NSA_DSR4(a0, a1, a2, a3, base + kra[0]); NSA_DSR4(b0, b1, b2, b3, base + kra[1]);
    NSA_WAIT4(4, a0, a1, a2, a3);
    s[0] = __builtin_amdgcn_mfma_f32_16x16x32_bf16(a0, qf[0], z, 0, 0, 0); s[1] = __builtin_amdgcn_mfma_f32_16x16x32_bf16(a1, qf[0], z, 0, 0, 0);
    s[2] = __builtin_amdgcn_mfma_f32_16x16x32_bf16(a2, qf[0], z, 0, 0, 0); s[3] = __builtin_amdgcn_mfma_f32_16x16x32_bf16(a3, qf[0], z, 0, 0, 0);
    NSA_DSR4(a0, a1, a2, a3, base + kra[2]);
    NSA_WAIT4(4, b0, b1, b2, b3);
    s[0] = __builtin_amdgcn_mfma_f32_16x16x32_bf16(b0, qf[1], s[0], 0, 0, 0); s[1] = __builtin_amdgcn_mfma_f32_16x16x32_bf16(b1, qf[1], s[1], 0, 0, 0);
    s[2] = __builtin_amdgcn_mfma_f32_16x16x32_bf16(b2, qf[1], s[2], 0, 0, 0); s[3] = __builtin_amdgcn_mfma_f32_16x16x32_bf16(b3, qf[1], s[3], 0, 0, 0);
    NSA_DSR4(b0, b1, b2, b3, base + kra[3]);
    NSA_WAIT4(4, a0, a1, a2, a3);
    s[0] = __builtin_amdgcn_mfma_f32_16x16x32_bf16(a0, qf[2], s[0], 0, 0, 0); s[1] = __builtin_amdgcn_mfma_f32_16x16x32_bf16(a1, qf[2], s[1], 0, 0, 0);
    s[2] = __builtin_amdgcn_mfma_f32_16x16x32_bf16(a2, qf[2], s[2], 0, 0, 0); s[3] = __builtin_amdgcn_mfma_f32_16x16x32_bf16(a3, qf[2], s[3], 0, 0, 0);
    NSA_WAIT4(0, b0, b1, b2, b3);
    s[0] = __builtin_amdgcn_mfma_f32_16x16x32_bf16(b0, qf[3], s[0], 0, 0, 0); s[1] = __builtin_amdgcn_mfma_f32_16x16x32_bf16(b1, qf[3], s[1], 0, 0, 0);
    s[2] = __builtin_amdgcn_mfma_f32_16x16x32_bf16(b2, qf[3], s[2], 0, 0, 0); s[3] = __builtin_amdgcn_mfma_f32_16x16x32_bf16(b3, qf[3], s[3], 0, 0, 0);
}

#define NSA_DSR8(v, A0, A1, A2, A3, O0, O1) asm volatile( \
        "ds_read_b64 %0, %8 offset:%12\n\tds_read_b64 %1, %9 offset:%12\n\tds_read_b64 %2, %10 offset:%12\n\tds_read_b64 %3, %11 offset:%12\n\t" \
        "ds_read_b64 %4, %8 offset:%13\n\tds_read_b64 %5, %9 offset:%13\n\tds_read_b64 %6, %10 offset:%13\n\tds_read_b64 %7, %11 offset:%13" \
        : "=&v"(v[0]), "=&v"(v[1]), "=&v"(v[2]), "=&v"(v[3]), "=&v"(v[4]), "=&v"(v[5]), "=&v"(v[6]), "=&v"(v[7]) : "v"(A0), "v"(A1), "v"(A2), "v"(A3), "i"(O0), "i"(O1) : "memory")
#define NSA_WAIT8(n, v) asm volatile("s_waitcnt lgkmcnt(" #n ")" : "+v"(v[0]), "+v"(v[1]), "+v"(v[2]), "+v"(v[3]), "+v"(v[4]), "+v"(v[5]), "+v"(v[6]), "+v"(v[7]) :: "memory")
template <int AM>
DI void pv_tile(SubState& st, const bf16x8 (&pf)[2][2], const LAS unsigned char* sl, const int (&vra)[4]) {
    const unsigned base = (unsigned)(size_t)sl; const unsigned A0 = base + vra[0], A1 = base + vra[1], A2 = base + vra[2], A3 = base + vra[3];
    s16x4 va[8], vb[8];
#define PV_MMA(src, grp) do { _Pragma("unroll") for (int kk_ = 0; kk_ < 2; ++kk_) _Pragma("unroll") for (int d_ = 0; d_ < 2; ++d_) { \
        const bf16x8 vf_ = __builtin_shufflevector(src[d_ * 4 + kk_ * 2], src[d_ * 4 + kk_ * 2 + 1], 0, 1, 2, 3, 4, 5, 6, 7); \
        if (AM & 1) st.o[0][(grp) * 2 + d_] = __builtin_amdgcn_mfma_f32_16x16x32_bf16(vf_, pf[0][kk_], st.o[0][(grp) * 2 + d_], 0, 0, 0); \
        if (AM & 2) st.o[1][(grp) * 2 + d_] = __builtin_amdgcn_mfma_f32_16x16x32_bf16(vf_, pf[1][kk_], st.o[1][(grp) * 2 + d_], 0, 0, 0); } } while (0)
    NSA_DSR8(va, A0, A1, A2, A3, 0, 2048); NSA_DSR8(vb, A0, A1, A2, A3, 4096, 6144);
    NSA_WAIT8(8, va); PV_MMA(va, 0);
    NSA_DSR8(va, A0, A1, A2, A3, 8192, 10240);
    NSA_WAIT8(8, vb); PV_MMA(vb, 1);
    NSA_DSR8(vb, A0, A1, A2, A3, 12288, 14336);
    NSA_WAIT8(8, va); PV_MMA(va, 2);
    NSA_WAIT8(0, vb); PV_MMA(vb, 3);
#undef PV_MMA
}

template <int BR>
DI void run_branch(const bf16_t* __restrict__ Ksrc, size_t kstride, const bf16_t* __restrict__ Vsrc, size_t vstride, int tile_lo, int ntiles,
                   const bf16x8 (&q)[2][4], SubState& st, int t0, int qb, const int (&tokl)[2], LAS unsigned char* lds) {
    constexpr bool WITHV = (BR != 0);
    constexpr int TPR = (BR != 1) ? 2 : 1, RING0 = (BR != 1) ? 0 : 2 * SLOT;
    const int tid = TID(), w = __builtin_amdgcn_readfirstlane(tid >> 6), lane = tid & 63, fr = lane & 15, fq = lane >> 4;
    LAS float* IMP = (LAS float*)(lds + IMP_OFF); LAS unsigned* SEL = (LAS unsigned*)(lds + SEL_OFF);
    unsigned kof[2], vof[2];
#pragma unroll
    for (int i = 0; i < 2; ++i) { const int row = (i * 8 + w) * 4 + (lane >> 4), ch = (lane & 15) ^ (row & 15); kof[i] = (unsigned)row * (unsigned)kstride + ch * 8;
        const int dim = (i * 8 + w) * 8 + (lane >> 3), cv = (lane & 7) ^ ((dim >> 1) & 7); vof[i] = (unsigned)dim * (unsigned)vstride + cv * 8; }
    int kra[4], vra[4];
#pragma unroll
    for (int ks = 0; ks < 4; ++ks) kra[ks] = fr * 256 + (((ks * 4 + fq) ^ (fr & 15)) << 4);
#pragma unroll
    for (int c = 0; c < 4; ++c) vra[c] = VT_IN_SLOT + fr * 128 + ((((c << 1) | (fq >> 1)) ^ ((fr >> 1) & 7)) << 4) + (fq & 1) * 8;
#define NSA_ISSUE(rr, bb) do { _Pragma("unroll") for (int u_ = 0; u_ < TPR; ++u_) { const int t_ = (rr) * TPR + u_; if (t_ < ntiles) { const int tile_ = tile_lo + t_; \
        LAS unsigned char* sl_ = lds + RING0 + ((bb) * TPR + u_) * SLOT; const bf16_t* kb_ = Ksrc + (size_t)tile_ * 64 * kstride; const bf16_t* vb_ = Vsrc + (size_t)tile_ * 64; \
        _Pragma("unroll") for (int i_ = 0; i_ < 2; ++i_) { \
            __builtin_amdgcn_global_load_lds((const unsigned*)(kb_ + kof[i_]), (LAS unsigned*)(sl_ + (i_ * 8 + w) * 1024), 16, 0, 0); \
            if (WITHV) __builtin_amdgcn_global_load_lds((const unsigned*)(vb_ + vof[i_]), (LAS unsigned*)(sl_ + VT_IN_SLOT + (i_ * 8 + w) * 1024), 16, 0, 0); } } } } while (0)
    const int nr = (ntiles + TPR - 1) / TPR;
    __syncthreads();
    NSA_ISSUE(0, 0);
    for (int r = 0; r < nr; ++r) {
        asm volatile("s_waitcnt vmcnt(0)" ::: "memory");
        __syncthreads();
        if (r + 1 < nr) NSA_ISSUE(r + 1, (r + 1) & 1);
#pragma unroll
        for (int u = 0; u < TPR; ++u) {
            const int t = r * TPR + u; if (t >= ntiles) break;
            const int tile = tile_lo + t, k0 = tile * 64;
            const LAS unsigned char* sl = lds + RING0 + ((r & 1) * TPR + u) * SLOT;
            bool act[2] = {true, true}; bool selbit[2] = {true, true};
            if (BR == 2) {
#pragma unroll
                for (int sb = 0; sb < 2; ++sb) { selbit[sb] = ((SEL[tokl[sb] * 8 + (tile >> 5)] >> (tile & 31)) & 1u) != 0u; act[sb] = __any(selbit[sb]) != 0; }
                if (!act[0] && !act[1]) continue;
            }
            bool need_mask;
            if (BR <= 1) need_mask = (k0 + 63) > ((t0 - 31) >> 4);
            else if (BR == 2) need_mask = (tile == qb);
            else need_mask = (tile == qb) || (tile == qb - 8);
            bf16x8 pf[2][2];
#pragma unroll
            for (int sb = 0; sb < 2; ++sb) {
                if (!act[sb]) continue;
                f32x4 s[4];
                qk_tile(s, sl, kra, q[sb]);
                if (need_mask) {
                    const int tok = t0 + tokl[sb]; const int kb = k0 + 4 * fq;
#pragma unroll
                    for (int kt = 0; kt < 4; ++kt)
#pragma unroll
                        for (int j = 0; j < 4; ++j) { const int key = kb + 16 * kt + j; bool valid;
                            if (BR <= 1) valid = key <= ((tok - 31) >> 4);
                            else if (BR == 2) valid = key <= tok;
                            else valid = key <= tok && key > tok - 512;
                            s[kt][j] = valid ? s[kt][j] : -__builtin_inff(); }
                }
                if (BR == 0) {
                    float mx = fmaxf(fmaxf(s[0][0], s[0][1]), fmaxf(s[0][2], s[0][3]));
#pragma unroll
                    for (int kt = 1; kt < 4; ++kt) mx = fmaxf(mx, fmaxf(fmaxf(s[kt][0], s[kt][1]), fmaxf(s[kt][2], s[kt][3])));
                    const float mn = fmaxf(st.m[sb], mx), mc0 = -mn * C2; float sum = 0.f;
#pragma unroll
                    for (int kt = 0; kt < 4; ++kt)
#pragma unroll
                        for (int j = 0; j < 4; ++j) sum += __builtin_amdgcn_exp2f(__builtin_fmaf(s[kt][j], C2, mc0));
                    st.l[sb] = st.l[sb] * __builtin_amdgcn_exp2f((st.m[sb] - mn) * C2) + sum; st.m[sb] = mn;
                    continue;
                }
                if (BR == 1) {
                    const float mc1 = -st.m[sb] * C2, il = st.l[sb];
#pragma unroll
                    for (int kt = 0; kt < 4; ++kt)
#pragma unroll
                        for (int j = 0; j < 4; ++j) s[kt][j] = __builtin_amdgcn_exp2f(__builtin_fmaf(s[kt][j], C2, mc1)) * il;
                    float prev = st.carry[sb];
#pragma unroll
                    for (int kt = 0; kt < 4; ++kt) { const float a = quad_sum(2.f * (s[kt][0] + s[kt][1] + s[kt][2]) + s[kt][3]), c3 = quad_sum(s[kt][3]);
                        const float rot = __shfl(c3, (lane - 16) & 63); const float recv = (fq == 0) ? prev : rot; prev = rot;
                        if ((fr & 3) == 0) IMP[tokl[sb] * 256 + (k0 >> 2) + 4 * kt + fq] = a + recv; }
                    st.carry[sb] = prev;
                } else {
                    float mx = fmaxf(fmaxf(s[0][0], s[0][1]), fmaxf(s[0][2], s[0][3]));
#pragma unroll
                    for (int kt = 1; kt < 4; ++kt) mx = fmaxf(mx, fmaxf(fmaxf(s[kt][0], s[kt][1]), fmaxf(s[kt][2], s[kt][3])));
                    if (BR == 2) mx = selbit[sb] ? mx : -__builtin_inff();
                    mx = xmax32(xmax16(mx));
                    if (!__all(mx - st.m[sb] <= THR_RAW)) {
                        const float mn = fmaxf(st.m[sb], mx), alpha = __builtin_amdgcn_exp2f((st.m[sb] - mn) * C2); st.m[sb] = mn; st.la[sb] *= alpha;
#pragma unroll
                        for (int dt = 0; dt < 8; ++dt) st.o[sb][dt] *= alpha;
                    }
                    float mrow = st.m[sb]; if (BR == 2) mrow = selbit[sb] ? mrow : __builtin_inff();
                    const float mc2 = -mrow * C2;
#pragma unroll
                    for (int kt = 0; kt < 4; ++kt)
#pragma unroll
                        for (int j = 0; j < 4; ++j) s[kt][j] = __builtin_amdgcn_exp2f(__builtin_fmaf(s[kt][j], C2, mc2));
                }
#pragma unroll
                for (int kk = 0; kk < 2; ++kk) { u32x4 wq; wq.x = cvt_pk_bf16(s[2 * kk][0], s[2 * kk][1]); wq.y = cvt_pk_bf16(s[2 * kk][2], s[2 * kk][3]); wq.z = cvt_pk_bf16(s[2 * kk + 1][0], s[2 * kk + 1][1]); wq.w = cvt_pk_bf16(s[2 * kk + 1][2], s[2 * kk + 1][3]);
                    pf[sb][kk] = __builtin_bit_cast(bf16x8, wq); }
                if (BR >= 2) { const bf16x8 ones = (bf16x8){0x3f80, 0x3f80, 0x3f80, 0x3f80, 0x3f80, 0x3f80, 0x3f80, 0x3f80};
                    st.la[sb] = __builtin_amdgcn_mfma_f32_16x16x32_bf16(ones, pf[sb][0], st.la[sb], 0, 0, 0); st.la[sb] = __builtin_amdgcn_mfma_f32_16x16x32_bf16(ones, pf[sb][1], st.la[sb], 0, 0, 0); }
                if (BR == 2) { if (sb == 0) pv_tile<1>(st, pf, sl, vra); else pv_tile<2>(st, pf, sl, vra); }
            }
            if (BR == 1 || BR == 3) pv_tile<3>(st, pf, sl, vra);
        }
    }
#undef NSA_ISSUE
}

template <bool FIRST, bool NORMALIZE>
DI void branch_out(SubState& st, const float (&gl)[2], bf16_t* __restrict__ O, int tokg0, const int (&tokl)[2], int head, int fq) {
#pragma unroll
    for (int sb = 0; sb < 2; ++sb) {
        float f = 1.f;
        if (NORMALIZE) { const float l = st.la[sb][0]; f = l > 0.f ? 1.f / l : 0.f; }
        const size_t tok = (size_t)(tokg0 + tokl[sb]);
        f *= sigmoidf_(gl[sb]);
        bf16_t* op = O + tok * DM + head * 128 + 4 * fq;
        u32x2 oldv[8];
        if (!FIRST) {
#pragma unroll
            for (int dt = 0; dt < 8; ++dt) oldv[dt] = *(const u32x2*)(op + 16 * dt); }
#pragma unroll
        for (int dt = 0; dt < 8; ++dt) { f32x4 v = st.o[sb][dt] * f;
            if (!FIRST) { const u32x2 old = oldv[dt]; v[0] += bflo(old.x); v[1] += bfhi(old.x); v[2] += bflo(old.y); v[3] += bfhi(old.y); }
            u32x2 w; w.x = cvt_pk_bf16(v[0], v[1]); w.y = cvt_pk_bf16(v[2], v[3]); *(u32x2*)(op + 16 * dt) = w; }
    }
}
DI void reset_state(SubState& st) {
#pragma unroll
    for (int sb = 0; sb < 2; ++sb) { st.m[sb] = -1e30f; st.l[sb] = 0.f; st.carry[sb] = 0.f; st.la[sb] = (f32x4){0.f, 0.f, 0.f, 0.f};
#pragma unroll
        for (int dt = 0; dt < 8; ++dt) st.o[sb][dt] = (f32x4){0.f, 0.f, 0.f, 0.f}; }
}

DI void attn_phase(const bf16_t* __restrict__ QKV, const bf16_t* __restrict__ KC, const bf16_t* __restrict__ VCt, const bf16_t* __restrict__ VSt, const bf16_t* __restrict__ VWt,
                   bf16_t* __restrict__ O, LAS unsigned char* lds, unsigned* __restrict__ qctr) {
    const int tid = TID(), bid = BID(), w = tid >> 6, lane = tid & 63, fr = lane & 15, fq = lane >> 4;
    LAS float* IMP = (LAS float*)(lds + IMP_OFF); LAS unsigned* SEL = (LAS unsigned*)(lds + SEL_OFF);
    volatile LAS unsigned* bcast = (volatile LAS unsigned*)(lds + BARST_OFF + 8);
    const int bg = bid & 7, b = bg >> 2, g = bg & 3;
    for (;;) {
        __syncthreads();
        if (tid == 0) *bcast = __hip_atomic_fetch_add(qctr + bg * 16, 1u, __ATOMIC_RELAXED, __HIP_MEMORY_SCOPE_AGENT);
        __syncthreads();
        const int it = (int)*bcast; if (it >= 256) break;
        const int qb = 255 - it;
        const int t0 = qb * 64, tokg0 = b * TT + t0, head = g * 4 + (fr & 3);
        const int tokl[2] = {8 * w + (fr >> 2), 8 * w + 4 + (fr >> 2)};
        bf16x8 q[2][4];
#pragma unroll
        for (int sb = 0; sb < 2; ++sb)
#pragma unroll
            for (int ks = 0; ks < 4; ++ks) q[sb][ks] = *(const bf16x8*)(QKV + (size_t)(tokg0 + tokl[sb]) * NQKV + head * 128 + ks * 32 + fq * 8);
        float gatev[3][2];
#pragma unroll
        for (int br = 0; br < 3; ++br)
#pragma unroll
            for (int sb = 0; sb < 2; ++sb) gatev[br][sb] = bf2f(QKV[(size_t)(tokg0 + tokl[sb]) * NQKV + C_GL + br * 16 + head]);
        SubState st;
        const int ntc = ((4 * qb + 2) >> 6) + 1;
        const bf16_t* kc = KC + (size_t)bg * 1024 * 128; const bf16_t* vc = VCt + (size_t)bg * 128 * 1024;
        reset_state(st);
        run_branch<0>(kc, 128, vc, 1024, 0, ntc, q, st, t0, qb, tokl, lds);
#pragma unroll
        for (int sb = 0; sb < 2; ++sb) { const float m = xmax32(xmax16(st.m[sb]));
            const float l = xsum32(xsum16(st.l[sb] * __builtin_amdgcn_exp2f((st.m[sb] - m) * C2)));
            st.m[sb] = m; st.l[sb] = l > 0.f ? 1.f / l : 0.f; }
        run_branch<1>(kc, 128, vc, 1024, 0, ntc, q, st, t0, qb, tokl, lds);
        branch_out<true, false>(st, gatev[0], O, tokg0, tokl, head, fq);
        {
            const int ncand = qb - 2 > 0 ? qb - 2 : 0, Kc = 16 - (qb + 1 < 3 ? qb + 1 : 3);
            { constexpr int x0 = 0;
                unsigned key[8][4]; bool sel[8][4];
#pragma unroll
                for (int x = 0; x < 8; ++x)
#pragma unroll
                    for (int kk = 0; kk < 4; ++kk) { const int s = kk * 64 + lane; const bool cand = (s >= 1 && s <= qb - 2); key[x][kk] = cand ? (__float_as_uint(IMP[(8 * w + x0 + x) * 256 + s]) + 1u) : 0u; }
                if (ncand <= Kc) {
#pragma unroll
                    for (int x = 0; x < 8; ++x)
#pragma unroll
                        for (int kk = 0; kk < 4; ++kk) sel[x][kk] = key[x][kk] != 0u;
                } else {
                    unsigned prefix[8]; bool done[8] = {false, false, false, false, false, false, false, false}; int hb[8]; int hmax = -1;
#pragma unroll
                    for (int x = 0; x < 8; ++x) {
                        unsigned ko = 0u, kna = 0u;
#pragma unroll
                        for (int kk = 0; kk < 4; ++kk) { ko |= key[x][kk]; kna |= key[x][kk] ? ~key[x][kk] : 0u; }
                        ko = (unsigned)__builtin_amdgcn_readfirstlane((int)wave_or(ko)); kna = (unsigned)__builtin_amdgcn_readfirstlane((int)wave_or(kna));
                        const unsigned diff = ko & kna;
                        hb[x] = diff ? 31 - __builtin_clz(diff) : -1;
                        prefix[x] = hb[x] >= 31 ? 0u : (ko & ~((2u << (hb[x] < 0 ? 0 : hb[x])) - 1u));
                        if (hb[x] < 0) { prefix[x] = ko; done[x] = true; }
                        hmax = hb[x] > hmax ? hb[x] : hmax; }
                    for (int bit = hmax; bit >= 0; --bit) {
#pragma unroll
                        for (int x = 0; x < 8; ++x) { if (done[x] || bit > hb[x]) continue; const unsigned trial = prefix[x] | (1u << bit); int cnt = 0;
#pragma unroll
                            for (int kk = 0; kk < 4; ++kk) cnt += __popcll(__ballot(key[x][kk] >= trial));
                            if (cnt >= Kc) prefix[x] = trial;
                            if (cnt == Kc) done[x] = true; }
                        if (done[0] && done[1] && done[2] && done[3] && done[4] && done[5] && done[6] && done[7]) break; }
#pragma unroll
                    for (int x = 0; x < 8; ++x) { int ngt = 0;
#pragma unroll
                        for (int kk = 0; kk < 4; ++kk) ngt += __popcll(__ballot(key[x][kk] > prefix[x]));
                        int need = Kc - ngt;
#pragma unroll
                        for (int kk = 0; kk < 4; ++kk) { const bool eq = key[x][kk] == prefix[x]; const unsigned long long bal = __ballot(eq); const int rank = __popcll(bal & ((1ull << lane) - 1ull));
                            sel[x][kk] = key[x][kk] > prefix[x] || (eq && rank < need); const int tot = __popcll(bal); need -= (tot < need ? tot : need); } }
                }
#pragma unroll
                for (int x = 0; x < 8; ++x)
#pragma unroll
                    for (int kk = 0; kk < 4; ++kk) { const int s = kk * 64 + lane; const bool fs = sel[x][kk] || s == 0 || s == qb || s == qb - 1; const unsigned long long bal = __ballot(fs);
                        if (lane == 0) { SEL[(8 * w + x0 + x) * 8 + 2 * kk] = (unsigned)bal; SEL[(8 * w + x0 + x) * 8 + 2 * kk + 1] = (unsigned)(bal >> 32); } }
            }
        }
        reset_state(st);
        run_branch<2>(QKV + (size_t)(b * TT) * NQKV + C_KS + g * 128, NQKV, VSt + (size_t)bg * 128 * TT, TT, 0, qb + 1, q, st, t0, qb, tokl, lds);
        branch_out<false, true>(st, gatev[1], O, tokg0, tokl, head, fq);
        reset_state(st);
        { const int lo = qb - 8 > 0 ? qb - 8 : 0;
          run_branch<3>(QKV + (size_t)(b * TT) * NQKV + C_KW + g * 128, NQKV, VWt + (size_t)bg * 128 * TT, TT, lo, qb - lo + 1, q, st, t0, qb, tokl, lds); }
        branch_out<false, true>(st, gatev[2], O, tokg0, tokl, head, fq);
    }
}
}
constexpr size_t WS_WUP = 0, WS_WDN = 67108864, WS_WGATE = 134217728, WS_WPLE = 150994944, WS_WGIN = 153092096, WS_WGOUT = 169869312, WS_WNIN = 178257920, WS_WNOUT = 200278016,
                 WS_WC1 = 208666624, WS_WC2 = 217055232, WS_PBF = 217317376, WS_BIASP = 250871808, WS_BIAS = 250937344, WS_H = 250941440, WS_HB = 385159168, WS_S1 = 519376896,
                 WS_VST = 896864256, WS_VWT = 930418688, WS_HID = 963973120, WS_KC = 980750336, WS_VCT = 982847488,
                 WS_PARTA = 1056247808, WS_PARTB = 1060442112, WS_BAR = 1064636416, WS_END = 1064636416 + 16384;

struct Params {
    const float* x; const float* p; const float* norm_mix; const float* norm_ffn; const float* norm_ple; const float* ffn_up; const float* ffn_down; const float* ple_proj; const float* ple_gate;
    const float* gm_in; const float* gm_ln_g; const float* gm_ln_b; const float* gm_ws; const float* gm_bs; const float* gm_out;
    const float* nsa_in; const float* kc_pe; const float* kc_w1; const float* kc_w2; const float* vc_pe; const float* vc_w1; const float* vc_w2; const float* nsa_out; const float* final_norm;
    float* out; unsigned char* ws;
};

DI pg8::Gemm<0> mkgemm(const void* A, unsigned lda_bytes, const void* Bt, int N, int K) {
    pg8::Gemm<0> g; g.A = (const char*)A; g.Bt = (const char*)Bt; g.M = MT; g.N = N; g.nt = K / 64; g.lda = lda_bytes; g.ldb = (unsigned)K * 2u; g.kstep2 = 256u; return g;
}

__global__ void __launch_bounds__(NTHREADS, 2) mega(Params Parg) {
    extern __shared__ __attribute__((aligned(16))) unsigned char lds_raw[];
    LAS unsigned char* lds = (LAS unsigned char*)lds_raw;
    cg::grid_group grid = cg::this_grid();
    typedef const __attribute__((address_space(4))) Params* KP;
    const int G = gridDim.x;
    volatile LAS unsigned* barst = (volatile LAS unsigned*)(lds + BARST_OFF);
    if (threadIdx.x < 4) barst[threadIdx.x] = 0u;
    __syncthreads();
    (void)xcd_barrier_post((unsigned*)(Parg.ws + WS_BAR), barst);
    for (int step = 0; step <= 15; ++step) {
        const int ph = step < 12 ? step : (step < 15 ? step - 8 : 12), l = step >= 12 ? 1 : 0;
        KP Pk = (KP)__builtin_amdgcn_kernarg_segment_ptr(); asm volatile("" : "+s"(Pk));
#define P (*Pk)
        unsigned char* ws = P.ws;
        bf16_t* Wup = (bf16_t*)(ws + WS_WUP); bf16_t* Wdn = (bf16_t*)(ws + WS_WDN); bf16_t* Wgate = (bf16_t*)(ws + WS_WGATE); bf16_t* Wple = (bf16_t*)(ws + WS_WPLE);
        bf16_t* Wgin = (bf16_t*)(ws + WS_WGIN); bf16_t* Wgout = (bf16_t*)(ws + WS_WGOUT); bf16_t* Wnin = (bf16_t*)(ws + WS_WNIN); bf16_t* Wnout = (bf16_t*)(ws + WS_WNOUT);
        bf16_t* Wc1 = (bf16_t*)(ws + WS_WC1); bf16_t* Wc2 = (bf16_t*)(ws + WS_WC2); bf16_t* Pbf = (bf16_t*)(ws + WS_PBF); float* biasp = (float*)(ws + WS_BIASP); float* bias = (float*)(ws + WS_BIAS);
        bf16_t* H = (bf16_t*)(ws + WS_H); bf16_t* Hb = (bf16_t*)(ws + WS_HB); float* partA = (float*)(ws + WS_PARTA); float* partB = (float*)(ws + WS_PARTB); bf16_t* S1 = (bf16_t*)(ws + WS_S1);
        bf16_t* VSt = (bf16_t*)(ws + WS_VST); bf16_t* VWt = (bf16_t*)(ws + WS_VWT);
        bf16_t* HID = (bf16_t*)(ws + WS_HID); bf16_t* KC = (bf16_t*)(ws + WS_KC); bf16_t* VCt = (bf16_t*)(ws + WS_VCT);
        const int bid = BID();
        pg8::StaticOrder SO;
        switch (ph) {
        case 0: {
            LAS float* tile = (LAS float*)lds;
            for (int ll = 0; ll < 2; ++ll) {
                transpose_w(P.ffn_up + (size_t)ll * DM * DFF, Wup + (size_t)ll * DFF * DM, DM, DFF, DFF, tile);
                transpose_w(P.ffn_down + (size_t)ll * DFF * DM, Wdn + (size_t)ll * DM * DFF, DFF, DM, DM, tile);
                transpose_w(P.ple_gate + (size_t)ll * DM * DM, Wgate + (size_t)ll * DM * DM, DM, DM, DM, tile);
                transpose_w(P.ple_proj + (size_t)ll * PLE * DM, Wple + (size_t)ll * DM * PLE, PLE, DM, DM, tile);
            }
            transpose_w(P.gm_in, Wgin, DM, 4096, 4096, tile);
            transpose_w(P.gm_out, Wgout, DM, DM, DM, tile);
            transpose_w(P.nsa_in, Wnin, DM, NQKV_REAL, NQKV, tile);
            transpose_w(P.nsa_out, Wnout, DM, DM, DM, tile);
            transpose_w(P.kc_w1, Wc1, 4096, 512, 512, tile);
            transpose_w(P.vc_w1, Wc1 + (size_t)512 * 4096, 4096, 512, 512, tile);
            transpose_w(P.kc_w2, Wc2, 512, 128, 128, tile);
            transpose_w(P.vc_w2, Wc2 + (size_t)128 * 512, 512, 128, 128, tile);
            convert_f32_bf16(P.p, Pbf, (size_t)2 * MT * PLE);
            pe_bias_partial(P.kc_pe, P.kc_w1, P.vc_pe, P.vc_w1, biasp, tile);
            rmsnorm_bf16(P.x, P.norm_mix, H);
        } break;
        case 1: { auto g = mkgemm(H, DM * 2, Wgin, 4096, DM); SO.init(MT, 4096, G, bid); pg8::EpiAct<1, false> E{S1, 4096, nullptr, nullptr}; pg8::gemm_phase(lds, g, SO, E); } break;
        case 2: gmlp_gate(S1, P.gm_ln_g, P.gm_ln_b, P.gm_ws, P.gm_bs, H, lds); break;
        case 3: { auto g = mkgemm(H, DM * 2, Wgout, DM, DM); SO.init(MT, DM, G, bid); pg8::EpiResN<false> E{P.x, P.out, nullptr, nullptr, P.norm_ffn, Hb, partA}; pg8::gemm_phase(lds, g, SO, E); } break;
        case 4: { auto g = mkgemm(Hb, DM * 2, Wup + (size_t)l * DFF * DM, DFF, DM); SO.init(MT, DFF, G, bid); pg8::EpiAct<2, false> E{S1, DFF, nullptr, partA}; pg8::gemm_phase(lds, g, SO, E); } break;
        case 5: { { auto g = mkgemm(S1, DFF * 2, Wdn + (size_t)l * DM * DFF, DM, DFF); SO.init(MT, DM, G, bid); pg8::EpiResN<false> E{P.out, P.out, nullptr, nullptr, P.norm_ple + l * DM, H, partB}; pg8::gemm_phase(lds, g, SO, E); }
                  { auto g = mkgemm(Pbf + (size_t)l * MT * PLE, PLE * 2, Wple + (size_t)l * DM * PLE, DM, PLE); SO.init(MT, DM, G, bid); pg8::EpiAct<0, false> E{Hb, DM, nullptr, nullptr}; pg8::gemm_phase(lds, g, SO, E); } } break;
        case 6: { auto g = mkgemm(H, DM * 2, Wgate + (size_t)l * DM * DM, DM, DM); SO.init(MT, DM, G, bid);
                  pg8::EpiResN<true> E{P.out, P.out, Hb, partB, P.norm_mix + DM, l == 0 ? Hb : nullptr, partA}; pg8::gemm_phase(lds, g, SO, E); } break;
        case 7: { { const int t = bid * NTHREADS + TID(); if (t < 1024) { const int kv = t >> 9, n = t & 511; float pv[16];
#pragma unroll
                      for (int ks = 0; ks < 16; ++ks) pv[ks] = biasp[(kv * 16 + ks) * 512 + n];
                      float a = 0.f;
#pragma unroll
                      for (int ks = 0; ks < 16; ++ks) a += pv[ks];
                      bias[t] = a; } }
                  auto g = mkgemm(Hb, DM * 2, Wnin, NQKV, DM); SO.init(MT, NQKV, G, bid); pg8::EpiAct<0, false> E{S1, NQKV, nullptr, partA}; pg8::gemm_phase(lds, g, SO, E); } break;
        case 8: { pg8::Gemm<1> g; g.A = (const char*)S1; g.Bt = (const char*)Wc1; g.M = 16384; g.N = 512; g.nt = 64; g.lda = 16u * NQKV * 2u; g.ldb = 4096u * 2u; g.kstep2 = NQKV * 2u;
                   SO.init(16384, 512, G, bid); pg8::EpiAct<1, true> E{HID, 512, bias, nullptr}; pg8::gemm_phase(lds, g, SO, E);
                   rope_qkv(S1, 128, G - 128); transpose_v(S1, VSt, VWt, 128, G - 128, lds); } break;
        case 9: compress2(HID, Wc2, KC, VCt); break;
        case 10: nsa::attn_phase(S1, KC, VCt, VSt, VWt, H, lds, (unsigned*)(ws + WS_BAR + 14336)); break;
        case 11: { auto g = mkgemm(H, DM * 2, Wnout, DM, DM); SO.init(MT, DM, G, bid); pg8::EpiResN<false> E{P.out, P.out, nullptr, nullptr, P.norm_ffn + DM, Hb, partA}; pg8::gemm_phase(lds, g, SO, E); } break;
        default: rmsnorm_f32_inplace(P.out, P.final_norm); break;
        }
        if (step < 15) { if (step == 0) grid.sync(); else { XcdBarrier xb; xb.bar = (unsigned*)(ws + WS_BAR); xb.x = xb_xcc_id(); xb.st = (volatile LAS unsigned*)(lds + BARST_OFF); xcd_barrier(xb); } }
#undef P
    }
}

extern "C" void kernel_launch(void* const* d_in, const int* in_sizes, int n_in, void* d_out, int out_size, void* d_ws, size_t ws_size, hipStream_t stream) {
    static int grid = 0;
    if (!grid) {
        int dev = 0, cus = 0, per_cu = 0; (void)hipGetDevice(&dev);
        (void)hipDeviceGetAttribute(&cus, hipDeviceAttributeMultiprocessorCount, dev);
        (void)hipFuncSetAttribute((const void*)mega, hipFuncAttributeMaxDynamicSharedMemorySize, LDS_BYTES);
        (void)hipOccupancyMaxActiveBlocksPerMultiprocessor(&per_cu, (const void*)mega, NTHREADS, LDS_BYTES);
        if (per_cu < 1) per_cu = 1;
        grid = cus * per_cu;
        if (n_in != 24 || ws_size < WS_END) fprintf(stderr, "kernel_launch: unexpected n_in %d / ws_size %zu\n", n_in, ws_size);
    }
    (void)hipMemsetAsync((unsigned char*)d_ws + WS_BAR, 0, 16384, stream);
    Params P{};
    const float** pp = (const float**)&P;
    for (int i = 0; i < 24; ++i) pp[i] = (const float*)d_in[i];
    P.out = (float*)d_out; P.ws = (unsigned char*)d_ws;
    void* args[] = {&P};
    hipError_t e = hipLaunchCooperativeKernel((void*)mega, dim3(grid), dim3(NTHREADS), args, LDS_BYTES, stream);
    if (e != hipSuccess) fprintf(stderr, "cooperative launch failed: %s (grid %d)\n", hipGetErrorString(e), grid);
}
```
